# Optimizing an MI355X kernel written in HIP

```python
import math
import jax, jax.numpy as jnp
from jax import lax
import numpy as np

D_MODEL = 1024
BATCH = 16
SEQ = 2048
DEPTH = 1
DEC_BATCH = 32
DEC_SEQ = 64
PAST_LEN = 1024

CHUNK = 64
QBLK = 128
N_HEADS = 8
N_KV_HEADS = 2
HEAD_DIM = 64
ATTN_WIDTH = N_HEADS * HEAD_DIM
KV_WIDTH = N_KV_HEADS * HEAD_DIM
ROT_DIM = HEAD_DIM // 4
ROPE_THETA = 500000.0
N_IDX_HEADS = 8
IDX_DIM = 64
TOPK_MAX = 256
SSM_WIDTH = D_MODEL // 2
SSM_GROUP = 16
N_SSM_GROUPS = SSM_WIDTH // SSM_GROUP
SSM_STATE = 64
NORM_EPS = 1e-6
SPLITS = (ATTN_WIDTH, KV_WIDTH, KV_WIDTH, N_IDX_HEADS * IDX_DIM, IDX_DIM, N_IDX_HEADS,
          ATTN_WIDTH, SSM_WIDTH, SSM_WIDTH, D_MODEL, D_MODEL)
IN_WIDTH = (2 * ATTN_WIDTH + 2 * KV_WIDTH + N_IDX_HEADS * IDX_DIM + IDX_DIM + N_IDX_HEADS
            + 2 * SSM_WIDTH + 2 * D_MODEL)

kernel_name = 'hybrid_dsa_s5_streaming_step'

F32 = jnp.float32


def rms_norm(x, g):
    xf = x.astype(F32)
    y = xf * lax.rsqrt(jnp.mean(xf * xf, axis=-1, keepdims=True) + NORM_EPS)
    return (y * g.astype(F32)).astype(x.dtype)


def split_cols(z):
    out, off = [], 0
    for w in SPLITS:
        out.append(z[..., off:off + w])
        off += w
    return out


def partial_rope(x, pos):
    half = ROT_DIM // 2
    inv = jnp.power(ROPE_THETA, -jnp.arange(half, dtype=F32) * (2.0 / ROT_DIM))
    ang = pos.astype(F32)[:, None] * inv[None, :]
    ang = ang.reshape((ang.shape[0],) + (1,) * (x.ndim - 3) + (half,))
    cos, sin = jnp.cos(ang), jnp.sin(ang)
    xf = x.astype(F32)
    x1, x2, rest = xf[..., :half], xf[..., half:ROT_DIM], xf[..., ROT_DIM:]
    out = jnp.concatenate([x1 * cos - x2 * sin, x2 * cos + x1 * sin, rest], axis=-1)
    return out.astype(x.dtype)


def dsa_attend(q, qi, wi, qpos, k_all, v_all, ki_all, kpos, n_sel):
    B, T = q.shape[0], q.shape[1]
    qb = QBLK if T % QBLK == 0 else T
    nblk = T // qb
    gather = jax.vmap(lambda a, i: a[i])
    kif = ki_all.astype(F32)
    kchunk = kpos // CHUNK

    def to_blocks(a):
        return jnp.swapaxes(a.reshape((B, nblk, qb) + a.shape[2:]), 0, 1)

    def one_block(blk):
        qb_, qib, wib, pb = blk
        s = jnp.einsum('bqhd,bsd->bqhs', qib.astype(F32), kif) * (IDX_DIM ** -0.5)
        score = jnp.einsum('bqh,bqhs->bqs', wib.astype(F32), jax.nn.relu(s))
        adm = kchunk[None, :] <= (pb // CHUNK)[:, None]
        score = jnp.where(adm[None], score, -jnp.inf)
        top_val, top_idx = lax.top_k(score, n_sel)
        valid = jnp.isfinite(top_val)
        k_sel = gather(k_all, top_idx).astype(F32)
        v_sel = gather(v_all, top_idx).astype(F32)
        qg = qb_.reshape(B, qb, N_KV_HEADS, N_HEADS // N_KV_HEADS, HEAD_DIM).astype(F32)
        logits = jnp.einsum('bqgrd,bqngd->bqgrn', qg, k_sel) * (HEAD_DIM ** -0.5)
        logits = jnp.where(valid[:, :, None, None, :], logits, -jnp.inf)
        p = jax.nn.softmax(logits, axis=-1)
        o = jnp.einsum('bqgrn,bqngd->bqgrd', p, v_sel)
        return o.reshape(B, qb, ATTN_WIDTH).astype(q.dtype)

    out = lax.map(one_block, (to_blocks(q), to_blocks(qi), to_blocks(wi), qpos.reshape(nblk, qb)))
    return jnp.swapaxes(out, 0, 1).reshape(B, T, ATTN_WIDTH)


def s5_discretize(lambda_re, lambda_im, log_dt, b_re, b_im):
    dt = jnp.exp(log_dt.astype(F32))[:, None]
    lr, li = lambda_re.astype(F32), lambda_im.astype(F32)
    mag = jnp.exp(lr * dt)
    ar, ai = mag * jnp.cos(li * dt), mag * jnp.sin(li * dt)
    den = lr * lr + li * li
    zr = ((ar - 1.0) * lr + ai * li) / den
    zi = (ai * lr - (ar - 1.0) * li) / den
    br, bi = b_re.astype(F32), b_im.astype(F32)
    bbar_re = zr[..., None] * br - zi[..., None] * bi
    bbar_im = zr[..., None] * bi + zi[..., None] * br
    return ar, ai, bbar_re, bbar_im


def complex_linear_combine(e1, e2):
    a1r, a1i, b1r, b1i = e1
    a2r, a2i, b2r, b2i = e2
    return (a2r * a1r - a2i * a1i, a2r * a1i + a2i * a1r,
            a2r * b1r - a2i * b1i + b2r, a2r * b1i + a2i * b1r + b2i)


def s5_mix(u, h0, lambda_re, lambda_im, log_dt, b_re, b_im, c_re, c_im, d_skip):
    B, T = u.shape[0], u.shape[1]
    ar, ai, bbr, bbi = s5_discretize(lambda_re, lambda_im, log_dt, b_re, b_im)
    ug = u.astype(F32).reshape(B, T, N_SSM_GROUPS, SSM_GROUP)
    bu_re = jnp.einsum('btgc,gpc->btgp', ug, bbr)
    bu_im = jnp.einsum('btgc,gpc->btgp', ug, bbi)
    if h0 is not None:
        h0r, h0i = h0[0].astype(F32), h0[1].astype(F32)
        bu_re = bu_re.at[:, 0].add(ar * h0r - ai * h0i)
        bu_im = bu_im.at[:, 0].add(ar * h0i + ai * h0r)
    a_re = jnp.broadcast_to(ar, bu_re.shape)
    a_im = jnp.broadcast_to(ai, bu_im.shape)
    _, _, h_re, h_im = lax.associative_scan(complex_linear_combine, (a_re, a_im, bu_re, bu_im), axis=1)
    y = (jnp.einsum('gcp,btgp->btgc', c_re.astype(F32), h_re)
         - jnp.einsum('gcp,btgp->btgc', c_im.astype(F32), h_im))
    y = y.reshape(B, T, SSM_WIDTH) + d_skip.astype(F32) * u.astype(F32)
    return y, h_re[:, -1], h_im[:, -1]


def hybrid_layer(x, c, pos, past, prm):
    (w_mod, b_mod, g_norm, w_in, lambda_re, lambda_im, log_dt, ssm_b_re, ssm_b_im,
     ssm_c_re, ssm_c_im, d_skip, w_glu, w_attn_proj, w_ssm_proj, w_out) = prm
    B, T, _ = x.shape
    mod = jax.nn.silu(c) @ w_mod + b_mod
    shift, scale, gate = mod[:, :D_MODEL], mod[:, D_MODEL:2 * D_MODEL], mod[:, 2 * D_MODEL:]
    h = rms_norm(x, g_norm) * (1.0 + scale[:, None, :]) + shift[:, None, :]
    z = h @ w_in
    zq, zk, zv, zqi, zki, zwi, zga, zu, zgs, zma, zmb = split_cols(z)
    q = partial_rope(zq.reshape(B, T, N_HEADS, HEAD_DIM), pos)
    k = partial_rope(zk.reshape(B, T, N_KV_HEADS, HEAD_DIM), pos)
    v = zv.reshape(B, T, N_KV_HEADS, HEAD_DIM)
    qi = partial_rope(zqi.reshape(B, T, N_IDX_HEADS, IDX_DIM), pos)
    ki = partial_rope(zki, pos)
    wi = zwi * (N_IDX_HEADS ** -0.5)
    if past is None:
        k_all, v_all, ki_all, kpos, h0 = k, v, ki, pos, None
    else:
        ck, cv, cki, h0r, h0i = past
        k_all = jnp.concatenate([ck.astype(k.dtype), k], axis=1)
        v_all = jnp.concatenate([cv.astype(v.dtype), v], axis=1)
        ki_all = jnp.concatenate([cki.astype(ki.dtype), ki], axis=1)
        kpos = jnp.arange(k_all.shape[1], dtype=jnp.int32)
        h0 = (h0r, h0i)
    n_sel = min(TOPK_MAX, k_all.shape[1] // 4)
    o_attn = dsa_attend(q, qi, wi, pos, k_all, v_all, ki_all, kpos, n_sel)
    branch_a = (o_attn * jax.nn.silu(zga)) @ w_attn_proj
    y_ssm, h_re, h_im = s5_mix(zu, h0, lambda_re, lambda_im, log_dt, ssm_b_re, ssm_b_im,
                               ssm_c_re, ssm_c_im, d_skip)
    g_lin = jax.nn.gelu(y_ssm).astype(x.dtype) @ w_glu
    y_glu = g_lin[..., :SSM_WIDTH] * jax.nn.sigmoid(g_lin[..., SSM_WIDTH:])
    branch_b = (y_glu.astype(x.dtype) * jax.nn.silu(zgs)) @ w_ssm_proj
    merged = jax.nn.sigmoid(zma) * branch_a + jax.nn.sigmoid(zmb) * branch_b
    x = x + gate[:, None, :] * (merged @ w_out)
    return x, k, v, ki, h_re, h_im


def setup_inputs(seed: int = 0) -> dict:
    key = jax.random.key(seed)
    ks = jax.random.split(key, 32)

    def nrm(k, shape, s):
        return jax.random.normal(k, shape, F32) * s

    G, P, C = N_SSM_GROUPS, SSM_STATE, SSM_GROUP
    return {
        'x_prompt': nrm(ks[0], (BATCH, SEQ, D_MODEL), 1.0),
        'x_sample': nrm(ks[1], (DEC_BATCH, DEC_SEQ, D_MODEL), 1.0),
        'cache_k': nrm(ks[2], (DEPTH, DEC_BATCH, PAST_LEN, N_KV_HEADS, HEAD_DIM), 1.0),
        'cache_v': nrm(ks[3], (DEPTH, DEC_BATCH, PAST_LEN, N_KV_HEADS, HEAD_DIM), 1.0),
        'cache_idx_k': nrm(ks[4], (DEPTH, DEC_BATCH, PAST_LEN, IDX_DIM), 1.0),
        'state_ssm_re': nrm(ks[5], (DEPTH, DEC_BATCH, G, P), 0.1),
        'state_ssm_im': nrm(ks[6], (DEPTH, DEC_BATCH, G, P), 0.1),
        'c_prompt': nrm(ks[7], (BATCH, D_MODEL), 1.0),
        'c_sample': nrm(ks[8], (DEC_BATCH, D_MODEL), 1.0),
        'w_mod': nrm(ks[9], (DEPTH, D_MODEL, 3 * D_MODEL), 0.5 * D_MODEL ** -0.5),
        'b_mod': nrm(ks[10], (DEPTH, 3 * D_MODEL), 0.02),
        'g_norm': 1.0 + nrm(ks[11], (DEPTH, D_MODEL), 0.02),
        'w_in': nrm(ks[12], (DEPTH, D_MODEL, IN_WIDTH), D_MODEL ** -0.5),
        'lambda_re': -0.5 + nrm(ks[13], (DEPTH, G, P), 0.01),
        'lambda_im': math.pi * jnp.arange(P, dtype=F32) + nrm(ks[14], (DEPTH, G, P), 0.01),
        'log_dt': jax.random.uniform(ks[15], (DEPTH, G), F32, math.log(1e-3), math.log(1e-1)),
        'ssm_b_re': nrm(ks[16], (DEPTH, G, P, C), (2 * C) ** -0.5),
        'ssm_b_im': nrm(ks[17], (DEPTH, G, P, C), (2 * C) ** -0.5),
        'ssm_c_re': nrm(ks[18], (DEPTH, G, C, P), P ** -0.5),
        'ssm_c_im': nrm(ks[19], (DEPTH, G, C, P), P ** -0.5),
        'd_skip': nrm(ks[20], (DEPTH, SSM_WIDTH), 1.0),
        'w_glu': nrm(ks[21], (DEPTH, SSM_WIDTH, 2 * SSM_WIDTH), SSM_WIDTH ** -0.5),
        'w_attn_proj': nrm(ks[22], (DEPTH, ATTN_WIDTH, D_MODEL), ATTN_WIDTH ** -0.5),
        'w_ssm_proj': nrm(ks[23], (DEPTH, SSM_WIDTH, D_MODEL), SSM_WIDTH ** -0.5),
        'w_out': nrm(ks[24], (DEPTH, D_MODEL, D_MODEL), D_MODEL ** -0.5),
        'g_final': 1.0 + nrm(ks[25], (D_MODEL,), 0.02),
    }


def reference(x_prompt, x_sample, cache_k, cache_v, cache_idx_k, state_ssm_re, state_ssm_im,
              c_prompt, c_sample, w_mod, b_mod, g_norm, w_in, lambda_re, lambda_im, log_dt,
              ssm_b_re, ssm_b_im, ssm_c_re, ssm_c_im, d_skip, w_glu, w_attn_proj, w_ssm_proj,
              w_out, g_final):
    pos_p = jnp.arange(x_prompt.shape[1], dtype=jnp.int32)
    past_len = cache_k.shape[2]
    pos_s = past_len + jnp.arange(x_sample.shape[1], dtype=jnp.int32)
    xp, xs = x_prompt, x_sample
    kp_l, vp_l, kip_l, hrp_l, hip_l = [], [], [], [], []
    ks_l, vs_l, kis_l, hrs_l, his_l = [], [], [], [], []
    for l in range(DEPTH):
        prm = (w_mod[l], b_mod[l], g_norm[l], w_in[l], lambda_re[l], lambda_im[l], log_dt[l],
               ssm_b_re[l], ssm_b_im[l], ssm_c_re[l], ssm_c_im[l], d_skip[l], w_glu[l],
               w_attn_proj[l], w_ssm_proj[l], w_out[l])
        xp, kp, vp, kip, hrp, hip = hybrid_layer(xp, c_prompt, pos_p, None, prm)
        past = (cache_k[l], cache_v[l], cache_idx_k[l], state_ssm_re[l], state_ssm_im[l])
        xs, ks_, vs_, kis, hrs, his = hybrid_layer(xs, c_sample, pos_s, past, prm)
        kp_l.append(kp); vp_l.append(vp); kip_l.append(kip)
        hrp_l.append(hrp.astype(state_ssm_re.dtype)); hip_l.append(hip.astype(state_ssm_im.dtype))
        ks_l.append(ks_); vs_l.append(vs_); kis_l.append(kis)
        hrs_l.append(hrs.astype(state_ssm_re.dtype)); his_l.append(his.astype(state_ssm_im.dtype))
    y_prompt = rms_norm(xp, g_final)
    y_sample = rms_norm(xs, g_final)
    return (y_prompt, y_sample,
            jnp.stack(kp_l), jnp.stack(vp_l), jnp.stack(kip_l), jnp.stack(hrp_l), jnp.stack(hip_l),
            jnp.stack(ks_l), jnp.stack(vs_l), jnp.stack(kis_l), jnp.stack(hrs_l), jnp.stack(his_l))
```

```cpp
#include <hip/hip_runtime.h>
#include <hip/hip_cooperative_groups.h>
#include <cstdio>
namespace cg = cooperative_groups;

#ifndef MEGA
#define MEGA 1
#endif

typedef unsigned short bf16_t;
typedef short bf16x8 __attribute__((ext_vector_type(8)));
typedef float f32x16 __attribute__((ext_vector_type(16)));
typedef float f32x4 __attribute__((ext_vector_type(4)));
typedef float f32x2 __attribute__((ext_vector_type(2)));

constexpr int D = 1024, NP = 32768, NS = 2048, NTOK = NP + NS;
constexpr int NIN = 4936, NINP = 4992, NINP2 = 5120;
constexpr int SCLD = 2056;
constexpr int SMEM_BYTES = 143360;
constexpr int NTHREADS = 512;

constexpr size_t O_Y = 0;
constexpr size_t O_KP = (size_t)NTOK * 1024;
constexpr size_t O_VP = O_KP + (size_t)NP * 128;
constexpr size_t O_KIP = O_VP + (size_t)NP * 128;
constexpr size_t O_HRP = O_KIP + (size_t)NP * 64;
constexpr size_t O_HIP = O_HRP + 16 * 32 * 64;
constexpr size_t O_KS = O_HIP + 16 * 32 * 64;
constexpr size_t O_VS = O_KS + (size_t)NS * 128;
constexpr size_t O_KIS = O_VS + (size_t)NS * 128;
constexpr size_t O_HRS = O_KIS + (size_t)NS * 64;
constexpr size_t O_HIS = O_HRS + 32 * 32 * 64;

constexpr size_t al(size_t x) { return (x + 255) & ~(size_t)255; }
constexpr size_t W_CNT = 0;
constexpr size_t W_BAR = 256;
constexpr size_t W_WTIN = W_BAR + 3456 * 4;
constexpr size_t W_WTGLU = W_WTIN + al((size_t)NINP2 * 1024 * 2);
constexpr size_t W_WTAP = W_WTGLU + al((size_t)1024 * 512 * 2);
constexpr size_t W_WTSP = W_WTAP + al((size_t)1024 * 512 * 2);
constexpr size_t W_WTOUT = W_WTSP + al((size_t)1024 * 512 * 2);
constexpr size_t W_MODP = W_WTOUT + al((size_t)1024 * 1024 * 2);
constexpr size_t W_MODF = W_MODP + al((size_t)8 * 48 * 3072 * 4);
constexpr size_t W_ROPE = W_MODF + al((size_t)48 * 3072 * 4);
constexpr size_t W_BT = W_ROPE + al((size_t)2048 * 16 * 4);
constexpr size_t W_WE = W_BT + al((size_t)32 * 128 * 16 * 2);
constexpr size_t W_A1 = W_WE + al((size_t)32 * 128 * 512 * 2);
constexpr size_t W_A32 = W_A1 + al((size_t)32 * 64 * 2 * 4);
constexpr size_t W_CC = W_A32 + al((size_t)32 * 64 * 2 * 4);
constexpr size_t W_H = W_CC + al((size_t)32 * 16 * 128 * 2);
constexpr size_t W_Q = W_H + al((size_t)NTOK * 1024 * 2);
constexpr size_t W_QI = W_Q + al((size_t)NTOK * 512 * 2);
constexpr size_t W_WI = W_QI + al((size_t)NTOK * 512 * 2);
constexpr size_t W_KP = W_WI + al((size_t)NTOK * 8 * 4);
constexpr size_t W_VTP = W_KP + al((size_t)NP * 128 * 2);
constexpr size_t W_KIP = W_VTP + al((size_t)NP * 128 * 2);
constexpr size_t W_KS = W_KIP + al((size_t)NP * 64 * 2);
constexpr size_t W_VTS = W_KS + al((size_t)32 * 1088 * 128 * 2);
constexpr size_t W_KIS = W_VTS + al((size_t)32 * 1088 * 128 * 2);
constexpr size_t W_GA = W_KIS + al((size_t)32 * 1088 * 64 * 2);
constexpr size_t W_U = W_GA + al((size_t)NTOK * 512 * 2);
constexpr size_t W_GS = W_U + al((size_t)NTOK * 512 * 2);
constexpr size_t W_MA = W_GS + al((size_t)NTOK * 512 * 2);
constexpr size_t W_MB = W_MA + al((size_t)NTOK * 1024 * 2);
constexpr size_t W_E = W_MB + al((size_t)NTOK * 1024 * 2);
constexpr size_t W_END = W_E + al((size_t)1088 * 32 * 128 * 4);

struct Params {
    const float *x_prompt, *x_sample, *cache_k, *cache_v, *cache_idx_k, *st_re, *st_im, *c_prompt, *c_sample;
    const float *w_mod, *b_mod, *g_norm, *w_in, *lam_re, *lam_im, *log_dt, *b_re, *b_im, *c_re, *c_im, *d_skip;
    const float *w_glu, *w_ap, *w_sp, *w_out, *g_final;
    float* out;
    char* ws;
};

__device__ __forceinline__ unsigned pack2(float lo, float hi) {
    unsigned r;
    asm("v_cvt_pk_bf16_f32 %0, %1, %2" : "=v"(r) : "v"(lo), "v"(hi));
    return r;
}
__device__ __forceinline__ bf16_t f2bf(float f) { return (bf16_t)(pack2(f, 0.f) & 0xffffu); }
__device__ __forceinline__ float bf2f(bf16_t b) { return __uint_as_float(((unsigned)b) << 16); }
__device__ __forceinline__ float bflo(unsigned u) { return __uint_as_float(u << 16); }
__device__ __forceinline__ float bfhi(unsigned u) { return __uint_as_float(u & 0xffff0000u); }
__device__ __forceinline__ float fexp2(float x) { return __builtin_amdgcn_exp2f(x); }
__device__ __forceinline__ float frcp(float x) { return __builtin_amdgcn_rcpf(x); }
__device__ __forceinline__ float sigmoidf_(float x) { return frcp(1.f + fexp2(-1.44269504f * x)); }
__device__ __forceinline__ float siluf_(float x) { return x * sigmoidf_(x); }
__device__ __forceinline__ float geluf_(float x) {
    const float inner = x * (1.f + 0.044715f * x * x);
    return x * frcp(1.f + fexp2(-2.f * 0.7978845608f * 1.44269504f * inner));
}
__device__ __forceinline__ void sincos_big(float ang, float& s, float& c) {
    const float C_HI = 0.15915494309189535f;
    const float C_LO = 6.4206382e-09f;
    float p = ang * C_HI;
    float e = fmaf(ang, C_HI, -p) + ang * C_LO;
    float fr = p - rintf(p);
    fr += e;
    s = __builtin_amdgcn_sinf(fr);
    c = __builtin_amdgcn_cosf(fr);
}
__device__ __forceinline__ const float* xrow(const Params& P, int tok) {
    return tok < NP ? P.x_prompt + (size_t)tok * D : P.x_sample + (size_t)(tok - NP) * D;
}
__device__ __forceinline__ int modrow(int tok) { return tok < NP ? (tok >> 11) : 16 + ((tok - NP) >> 6); }
__device__ __forceinline__ void st_bf4(bf16_t* p, float a, float b, float c, float d) {
    uint2 v; v.x = pack2(a, b); v.y = pack2(c, d);
    *(uint2*)p = v;
}
__device__ __forceinline__ size_t kf_index(int bg, int nt, int key, int d0) {
    return ((((size_t)bg * nt + (key >> 5)) * 4 + ((d0 >> 3) & 3)) * 64 + (d0 >> 5) * 32 + (key & 31)) * 8 + (d0 & 7);
}
__device__ __forceinline__ size_t vf_index(int bg, int nt, int key, int d) {
    const int kk = key & 31, s2 = kk >> 4, r = kk & 15, hh = (r >> 2) & 1, j = (r >> 3) * 4 + (r & 3);
    return (((((size_t)bg * nt + (key >> 5)) * 2 + s2) * 2 + (d >> 5)) * 64 + hh * 32 + (d & 31)) * 8 + j;
}
#define MFMA32(a, b, c) __builtin_amdgcn_mfma_f32_32x32x16_bf16((a), (b), (c), 0, 0, 0)
#define MFMA16(a, b, c) __builtin_amdgcn_mfma_f32_16x16x32_bf16((a), (b), (c), 0, 0, 0)

template <int MODE>
__device__ __forceinline__ int colmap(int n) {
    if (MODE == 0) {
        if (n < 1352) return n;
        if (n < 1408 || n >= NINP) return -1;
        return n - 56;
    } else if (MODE == 1) {
        return (n >> 3) * 4 + ((n & 4) ? 512 : 0);
    } else return n;
}
template <int MODE>
__device__ __forceinline__ void transpose_tiles4(const float* __restrict__ src, int ldsrc, int K, bf16_t* __restrict__ dst, int t0, int ntn, char* smem) {
    const int tid = threadIdx.x;
    float4 v[4][2];
#pragma unroll
    for (int q = 0; q < 4; ++q) {
        const int kt = (t0 + q) / ntn, nt = (t0 + q) % ntn;
#pragma unroll
        for (int i = 0; i < 2; ++i) {
            const int k = (tid >> 4) + 32 * i, n4 = (tid & 15) * 4;
            const int sc = colmap<MODE>(nt * 64 + n4);
            v[q][i] = make_float4(0.f, 0.f, 0.f, 0.f);
            if (sc >= 0) v[q][i] = *(const float4*)(src + (size_t)(kt * 64 + k) * ldsrc + sc);
        }
    }
#pragma unroll
    for (int q = 0; q < 4; ++q) {
        bf16_t* tile = (bf16_t*)smem + q * (64 * 72);
#pragma unroll
        for (int i = 0; i < 2; ++i) {
            const int k = (tid >> 4) + 32 * i, n4 = (tid & 15) * 4;
            tile[(n4 + 0) * 72 + k] = f2bf(v[q][i].x);
            tile[(n4 + 1) * 72 + k] = f2bf(v[q][i].y);
            tile[(n4 + 2) * 72 + k] = f2bf(v[q][i].z);
            tile[(n4 + 3) * 72 + k] = f2bf(v[q][i].w);
        }
    }
    __syncthreads();
#pragma unroll
    for (int q = 0; q < 4; ++q) {
        const int kt = (t0 + q) / ntn, nt = (t0 + q) % ntn;
        const bf16_t* tile = (const bf16_t*)smem + q * (64 * 72);
        const int n = tid >> 3, ch = tid & 7;
        const uint4 w = *(const uint4*)(tile + n * 72 + ch * 8);
        *(uint4*)(dst + (size_t)(nt * 64 + n) * K + kt * 64 + ch * 8) = w;
    }
    __syncthreads();
}

__device__ __forceinline__ void phase0(const Params& P, char* smem) {
    const int bid = blockIdx.x, nb = gridDim.x, tid = threadIdx.x, lane = tid & 63, wave = tid >> 6;
    char* ws = P.ws;
    {
        float* csil = (float*)smem;
        float* red = (float*)(smem + 24576);
        float* modp = (float*)(ws + W_MODP);
        for (int task = bid; task < 384; task += nb) {
            const int jb = task % 48, ks = task / 48, k0 = ks * 128;
            for (int idx = tid; idx < 6144; idx += NTHREADS) {
                const int k = idx / 48, r = idx % 48;
                const float cv = r < 16 ? P.c_prompt[r * 1024 + k0 + k] : P.c_sample[(r - 16) * 1024 + k0 + k];
                csil[k * 48 + r] = siluf_(cv);
            }
            __syncthreads();
            float acc[48];
#pragma unroll
            for (int r = 0; r < 48; ++r) acc[r] = 0.f;
            float wpre[16];
#pragma unroll
            for (int kk = 0; kk < 16; ++kk) wpre[kk] = P.w_mod[(size_t)(k0 + 16 * wave + kk) * 3072 + jb * 64 + lane];
#pragma unroll
            for (int kk = 0; kk < 16; ++kk) {
                const int k = 16 * wave + kk;
                const float wv = wpre[kk];
#pragma unroll
                for (int r4 = 0; r4 < 12; ++r4) {
                    const float4 c4 = *(const float4*)(csil + k * 48 + 4 * r4);
                    acc[4 * r4 + 0] += wv * c4.x; acc[4 * r4 + 1] += wv * c4.y;
                    acc[4 * r4 + 2] += wv * c4.z; acc[4 * r4 + 3] += wv * c4.w;
                }
            }
#pragma unroll
            for (int r = 0; r < 48; ++r) red[(wave * 48 + r) * 64 + lane] = acc[r];
            __syncthreads();
            for (int idx = tid; idx < 3072; idx += NTHREADS) {
                const int r = idx >> 6, col = idx & 63;
                float s = 0.f;
#pragma unroll
                for (int w = 0; w < 8; ++w) s += red[(w * 48 + r) * 64 + col];
                modp[(size_t)(ks * 48 + r) * 3072 + jb * 64 + col] = s;
            }
            __syncthreads();
        }
    }
    {
        const int T_IN = 16 * 80 / 4, T_G = 8 * 16 / 4, T_O = 16 * 16 / 4;
        const int total = T_IN + 3 * T_G + T_O;
        for (int task = bid; task < total; task += nb) {
            int t = task;
            if (t < T_IN) { transpose_tiles4<0>(P.w_in, NIN, 1024, (bf16_t*)(ws + W_WTIN), t * 4, 80, smem); continue; }
            t -= T_IN;
            if (t < T_G) { transpose_tiles4<1>(P.w_glu, 1024, 512, (bf16_t*)(ws + W_WTGLU), t * 4, 16, smem); continue; }
            t -= T_G;
            if (t < T_G) { transpose_tiles4<2>(P.w_ap, 1024, 512, (bf16_t*)(ws + W_WTAP), t * 4, 16, smem); continue; }
            t -= T_G;
            if (t < T_G) { transpose_tiles4<2>(P.w_sp, 1024, 512, (bf16_t*)(ws + W_WTSP), t * 4, 16, smem); continue; }
            t -= T_G;
            transpose_tiles4<2>(P.w_out, 1024, 1024, (bf16_t*)(ws + W_WTOUT), t * 4, 16, smem);
        }
    }
    const int gtid = bid * NTHREADS + tid, gn = nb * NTHREADS;
    {
        float* rt = (float*)(ws + W_ROPE);
        for (int idx = gtid; idx < 2048 * 8; idx += gn) {
            const int pos = idx >> 3, f = idx & 7;
            const float inv = fexp2(-(float)f * 0.125f * 18.931568569324174f);
            float s, c;
            sincos_big((float)pos * inv, s, c);
            rt[pos * 16 + f] = c; rt[pos * 16 + 8 + f] = s;
        }
    }
    {
        bf16_t* Bt = (bf16_t*)(ws + W_BT);
        bf16_t* WE = (bf16_t*)(ws + W_WE);
        float* A1 = (float*)(ws + W_A1);
        float* A32 = (float*)(ws + W_A32);
        for (int idx = gtid; idx < 32 * 64 * 32; idx += gn) {
            const int s = idx & 31, gp = idx >> 5, g = gp >> 6, p = gp & 63;
            const float dt = __expf(P.log_dt[g]);
            const float lr = P.lam_re[gp], li = P.lam_im[gp];
            float sn, cs;
            sincos_big(li * dt, sn, cs);
            const float mag = __expf(lr * dt);
            const float ar = mag * cs, ai = mag * sn;
            const float den = lr * lr + li * li;
            const float zr = ((ar - 1.f) * lr + ai * li) / den;
            const float zi = (ai * lr - (ar - 1.f) * li) / den;
            if (s == 0) {
                A1[gp * 2] = ar; A1[gp * 2 + 1] = ai;
                float s32, c32;
                sincos_big(li * dt * 32.f, s32, c32);
                const float m32 = __expf(lr * dt * 32.f);
                A32[gp * 2] = m32 * c32; A32[gp * 2 + 1] = m32 * s32;
            }
            const float m = (float)(31 - s);
            float sp, cp;
            sincos_big(li * dt * m, sp, cp);
            const float mp = __expf(lr * dt * m);
            const float pr = mp * cp, pi = mp * sp;
#pragma unroll
            for (int c = 0; c < 16; ++c) {
                const float br = P.b_re[(size_t)gp * 16 + c], bi = P.b_im[(size_t)gp * 16 + c];
                const float bbr = zr * br - zi * bi, bbi = zr * bi + zi * br;
                if (s == 0) {
                    Bt[((size_t)g * 128 + p) * 16 + c] = f2bf(bbr);
                    Bt[((size_t)g * 128 + 64 + p) * 16 + c] = f2bf(bbi);
                }
                WE[((size_t)g * 128 + p) * 512 + s * 16 + c] = f2bf(pr * bbr - pi * bbi);
                WE[((size_t)g * 128 + 64 + p) * 512 + s * 16 + c] = f2bf(pr * bbi + pi * bbr);
            }
        }
        bf16_t* Cc = (bf16_t*)(ws + W_CC);
        for (int idx = gtid; idx < 32 * 16 * 128; idx += gn) {
            const int pos = idx & 127, gc = idx >> 7;
            const int pl = pos >> 2, ct = pos & 3;
            const int p = pl + 32 * (ct & 1);
            const float v = (ct >> 1) ? -P.c_im[(size_t)gc * 64 + p] : P.c_re[(size_t)gc * 64 + p];
            Cc[idx] = f2bf(v);
        }
    }
    {
        bf16_t* Ks = (bf16_t*)(ws + W_KS);
        bf16_t* KIs = (bf16_t*)(ws + W_KIS);
        bf16_t* Vts = (bf16_t*)(ws + W_VTS);
        for (int base = gtid; base < 32 * 1024 * 32; base += 8 * gn) {
            float4 v[8];
#pragma unroll
            for (int u = 0; u < 8; ++u) { const int idx = base + u * gn; if (idx < 32 * 1024 * 32) v[u] = *(const float4*)(P.cache_k + (size_t)idx * 4); }
#pragma unroll
            for (int u = 0; u < 8; ++u) {
                const int idx = base + u * gn;
                if (idx < 32 * 1024 * 32) {
                    const int c4 = idx & 31, bl = idx >> 5, b = bl >> 10, l = bl & 1023, c = c4 * 4;
                    st_bf4(Ks + kf_index(b * 2 + (c >> 6), 34, l, c & 63), v[u].x, v[u].y, v[u].z, v[u].w);
                }
            }
        }
        for (int base = gtid; base < 32 * 1024 * 16; base += 4 * gn) {
            float4 v[4];
#pragma unroll
            for (int u = 0; u < 4; ++u) { const int idx = base + u * gn; if (idx < 32 * 1024 * 16) v[u] = *(const float4*)(P.cache_idx_k + (size_t)idx * 4); }
#pragma unroll
            for (int u = 0; u < 4; ++u) {
                const int idx = base + u * gn;
                if (idx < 32 * 1024 * 16) {
                    const int c4 = idx & 15, bl = idx >> 4, b = bl >> 10, l = bl & 1023;
                    st_bf4(KIs + kf_index(b, 34, l, c4 * 4), v[u].x, v[u].y, v[u].z, v[u].w);
                }
            }
        }
        for (int base = gtid; base < 32 * 256 * 128; base += 4 * gn) {
            float v[4][4];
#pragma unroll
            for (int u = 0; u < 4; ++u) {
                const int idx = base + u * gn;
                if (idx < 32 * 256 * 128) {
                    const int gd = idx & 127, rest = idx >> 7, l4 = rest & 255, b = rest >> 8;
                    const float* src = P.cache_v + ((size_t)b * 1024 + l4 * 4) * 128 + gd;
                    v[u][0] = src[0]; v[u][1] = src[128]; v[u][2] = src[256]; v[u][3] = src[384];
                }
            }
#pragma unroll
            for (int u = 0; u < 4; ++u) {
                const int idx = base + u * gn;
                if (idx < 32 * 256 * 128) {
                    const int gd = idx & 127, rest = idx >> 7, l4 = rest & 255, b = rest >> 8;
                    st_bf4(Vts + vf_index(b * 2 + (gd >> 6), 34, l4 * 4, gd & 63), v[u][0], v[u][1], v[u][2], v[u][3]);
                }
            }
        }
    }
}

__device__ __forceinline__ void phase1(const Params& P, char* smem) {
    const int bid = blockIdx.x, nb = gridDim.x, tid = threadIdx.x, lane = tid & 63, wave = tid >> 6;
    char* ws = P.ws;
    const float* modp = (const float*)(ws + W_MODP);
    {
        float* modf = (float*)(ws + W_MODF);
        for (int idx = bid * NTHREADS + tid; idx < 48 * 3072; idx += nb * NTHREADS) {
            float s = P.b_mod[idx % 3072];
#pragma unroll
            for (int k = 0; k < 8; ++k) s += modp[(size_t)k * 48 * 3072 + idx];
            modf[idx] = s;
        }
    }
    float* gsc = (float*)smem;
    float* shf = gsc + 1024;
    bf16_t* H = (bf16_t*)(ws + W_H);
    for (int task = bid; task < NTOK / 64; task += nb) {
        const int tok0 = task * 64, r = modrow(tok0);
        for (int k = tid; k < 1024; k += NTHREADS) {
            float sh = P.b_mod[k], sc = P.b_mod[1024 + k];
#pragma unroll
            for (int s = 0; s < 8; ++s) {
                sh += modp[(size_t)(s * 48 + r) * 3072 + k];
                sc += modp[(size_t)(s * 48 + r) * 3072 + 1024 + k];
            }
            gsc[k] = P.g_norm[k] * (1.f + sc);
            shf[k] = sh;
        }
        __syncthreads();
        for (int rb = 0; rb < 2; ++rb) {
            float4 v[4][4];
#pragma unroll
            for (int r4 = 0; r4 < 4; ++r4) {
                const float* x = xrow(P, tok0 + wave * 8 + rb * 4 + r4);
#pragma unroll
                for (int i = 0; i < 4; ++i) v[r4][i] = *(const float4*)(x + 4 * lane + 256 * i);
            }
#pragma unroll
            for (int r4 = 0; r4 < 4; ++r4) {
                const int tok = tok0 + wave * 8 + rb * 4 + r4;
                float ss = 0.f;
#pragma unroll
                for (int i = 0; i < 4; ++i) ss += v[r4][i].x * v[r4][i].x + v[r4][i].y * v[r4][i].y + v[r4][i].z * v[r4][i].z + v[r4][i].w * v[r4][i].w;
#pragma unroll
                for (int o = 32; o >= 1; o >>= 1) ss += __shfl_xor(ss, o);
                const float rinv = rsqrtf(ss * (1.f / 1024.f) + 1e-6f);
#pragma unroll
                for (int i = 0; i < 4; ++i) {
                    const int k = 4 * lane + 256 * i;
                    const float4 g4 = *(const float4*)(gsc + k), s4 = *(const float4*)(shf + k);
                    st_bf4(H + (size_t)tok * 1024 + k, v[r4][i].x * rinv * g4.x + s4.x, v[r4][i].y * rinv * g4.y + s4.y,
                           v[r4][i].z * rinv * g4.z + s4.z, v[r4][i].w * rinv * g4.w + s4.w);
                }
            }
        }
        __syncthreads();
    }
}

namespace pg8 {
#define PG8_LAS __attribute__((address_space(3)))
constexpr int BM = 256, BK = 64, HALF = 128, HTB = HALF * BK * 2, STAGE_BYTES = 8 * HTB, NXCD = 8, WGM = 8;
__device__ __forceinline__ int lds_byte(int r, int c) { const int st = (r >> 4) * 2 + (c >> 5), rr = r & 15, cc = c & 31, ob = rr * 64 + cc * 2; return st * 1024 + (ob ^ (((ob >> 9) & 1) << 5)); }
__device__ __forceinline__ void stage_rc(int b, int& R, int& C) { const int st = b / 1024, sb = b % 1024, swz = sb ^ (((sb >> 9) & 1) << 5); R = (st >> 1) * 16 + swz / 64; C = (st & 1) * 32 + (swz % 64) / 2; }
__device__ __forceinline__ int perm32(int rho) { const int n = rho >> 4, i = rho & 15; return 8 * (i >> 2) + 4 * n + (i & 3); }
struct Unit { int pm, pn; };
struct Gemm { const bf16_t* A; const bf16_t* Bt; int M, N, K; };
struct StaticOrder {
    int nM, nN, nwg, G, c;
    __device__ void init(int M, int N, int G_, int c_) { nM = M / BM; nN = N / BM; nwg = nM * nN; G = G_; c = c_; }
    __device__ bool next(int i, Unit& u) const {
        const long L = (long)i * G + c; if (L >= nwg) return false;
        int wgid = (int)L; { const int q = nwg / NXCD, r = nwg % NXCD, xcd = wgid % NXCD, off = wgid / NXCD; wgid = (xcd < r ? xcd * (q + 1) : r * (q + 1) + (xcd - r) * q) + off; }
        const int nig = WGM * nN, gid = wgid / nig, fm = gid * WGM, gsz = (nM - fm) < WGM ? (nM - fm) : WGM;
        u.pm = fm + ((wgid % nig) % gsz); u.pn = (wgid % nig) / gsz; return true;
    }
};
template <class Epi>
__device__ __forceinline__ void gemm_phase(PG8_LAS unsigned char* lds, const Gemm g, const StaticOrder& S, const Epi& E) {
    int tid = threadIdx.x;
    asm volatile("" : "+v"(tid));
    const int wid = __builtin_amdgcn_readfirstlane(tid >> 6), lane = tid & 63, wr = wid >> 2, wc = wid & 3, fr = lane & 15, fq = lane >> 4;
    const int K = g.K, nt = K / BK;
    unsigned voffA[2], voffB[2];
#pragma unroll
    for (int i = 0; i < 2; ++i) { int R, C; stage_rc(tid * 16 + i * 8192, R, C); const int Rb = (R & ~31) + perm32(R & 31);
        voffA[i] = (unsigned)(R * K + C) * 2u; voffB[i] = (unsigned)(Rb * K + C) * 2u; }
    const size_t kstep = (size_t)(BK * 2);
    const size_t hstep = (size_t)HALF * K * 2;
    const size_t tstep = 2 * hstep;
    const unsigned ldsw = (unsigned)wid * 1024u;
    const int aoff = lds_byte(wr * 64 + fr, fq * 8), boff = lds_byte(wc * 32 + fr, fq * 8);
#define PG8_SA(b, h) (((b) * 2 + (h)) * HTB)
#define PG8_SB(b, h) ((4 + (b) * 2 + (h)) * HTB)
#define PG8_STAGE(bufoff, gbase, voff) do { _Pragma("unroll") for (int _i = 0; _i < 2; ++_i) \
        __builtin_amdgcn_global_load_lds((const unsigned*)((const char*)(gbase) + (voff)[_i]), (PG8_LAS unsigned*)(lds + (bufoff) + ldsw + _i * 8192), 16, 0, 0); } while (0)
#define PG8_LDA(dst, b, h) do { _Pragma("unroll") for (int m = 0; m < 4; ++m) _Pragma("unroll") for (int k = 0; k < 2; ++k) dst[m][k] = *(const PG8_LAS bf16x8*)(lds + PG8_SA(b, h) + aoff + m * 2048 + k * 1024); } while (0)
#define PG8_LDB(dst, b, h) do { _Pragma("unroll") for (int n = 0; n < 2; ++n) _Pragma("unroll") for (int k = 0; k < 2; ++k) dst[n][k] = *(const PG8_LAS bf16x8*)(lds + PG8_SB(b, h) + boff + n * 2048 + k * 1024); } while (0)
#define PG8_MMA(ai, bj, At, Bt) do { __builtin_amdgcn_s_setprio(1); _Pragma("unroll") for (int m = 0; m < 4; ++m) _Pragma("unroll") for (int n = 0; n < 2; ++n) _Pragma("unroll") for (int k = 0; k < 2; ++k) \
        acc[ai][bj][m][n] = __builtin_amdgcn_mfma_f32_16x16x32_bf16(Bt[n][k], At[m][k], acc[ai][bj][m][n], 0, 0, 0); __builtin_amdgcn_s_setprio(0); } while (0)
#define PG8_WAIT_V(n) asm volatile("s_waitcnt vmcnt(" #n ")" ::: "memory")
#define PG8_WAIT_L(n) asm volatile("s_waitcnt lgkmcnt(" #n ")" ::: "memory")
#define PG8_BAR __builtin_amdgcn_s_barrier()
#define PG8_SCHED __builtin_amdgcn_sched_barrier(0)
    Unit cur, nxt; int ui = 0;
    if (!S.next(0, cur)) return;
    f32x4 acc[2][2][4][2];
#pragma unroll
    for (int a = 0; a < 2; ++a)
#pragma unroll
        for (int b = 0; b < 2; ++b)
#pragma unroll
            for (int m = 0; m < 4; ++m)
#pragma unroll
                for (int n = 0; n < 2; ++n) acc[a][b][m][n] = (f32x4){0.f, 0.f, 0.f, 0.f};
    bf16x8 At[4][2], B0[2][2], B1[2][2];
    const char* cA = (const char*)g.A + (size_t)cur.pm * tstep; const char* cB = (const char*)g.Bt + (size_t)cur.pn * tstep;
    PG8_STAGE(PG8_SB(0, 0), cB, voffB); PG8_STAGE(PG8_SA(0, 0), cA, voffA); PG8_STAGE(PG8_SB(0, 1), cB + hstep, voffB); PG8_STAGE(PG8_SA(0, 1), cA + hstep, voffA);
    if (wr == 1) PG8_BAR;
    PG8_WAIT_V(4); PG8_BAR;
    PG8_STAGE(PG8_SB(1, 0), cB + kstep, voffB); PG8_STAGE(PG8_SA(1, 0), cA + kstep, voffA); PG8_STAGE(PG8_SB(1, 1), cB + hstep + kstep, voffB);
    PG8_WAIT_V(6); PG8_BAR;
    for (;;) {
        const bool has_next = S.next(ui + 1, nxt);
        const char* nA = has_next ? (const char*)g.A + (size_t)nxt.pm * tstep : cA; const char* nB = has_next ? (const char*)g.Bt + (size_t)nxt.pn * tstep : cB;
        for (int t = 0; t < nt; t += 2) {
            const bool last = (t == nt - 2);
            const char* a1 = cA + (size_t)(t + 1) * kstep;
            const char* a2 = last ? nA : cA + (size_t)(t + 2) * kstep; const char* b2 = last ? nB : cB + (size_t)(t + 2) * kstep;
            const char* a3 = a2 + kstep; const char* b3 = b2 + kstep;
            PG8_LDB(B0, 0, 0); PG8_SCHED; PG8_LDA(At, 0, 0); PG8_STAGE(PG8_SA(1, 1), a1 + hstep, voffA);
            PG8_WAIT_L(8); PG8_BAR; PG8_WAIT_L(0); PG8_MMA(0, 0, At, B0); PG8_BAR; PG8_SCHED;
            PG8_LDB(B1, 0, 1); PG8_STAGE(PG8_SB(0, 0), b2, voffB);
            PG8_BAR; PG8_WAIT_L(0); PG8_MMA(0, 1, At, B1); PG8_BAR;
            PG8_LDA(At, 0, 1); PG8_STAGE(PG8_SA(0, 0), a2, voffA);
            PG8_BAR; PG8_WAIT_L(0); PG8_MMA(1, 0, At, B0); PG8_BAR; PG8_SCHED;
            PG8_STAGE(PG8_SB(0, 1), b2 + hstep, voffB);
            PG8_WAIT_V(6); PG8_BAR; PG8_MMA(1, 1, At, B1); PG8_BAR;
            PG8_LDB(B0, 1, 0); PG8_SCHED; PG8_LDA(At, 1, 0); PG8_STAGE(PG8_SA(0, 1), a2 + hstep, voffA);
            PG8_WAIT_L(8); PG8_BAR; PG8_WAIT_L(0); PG8_MMA(0, 0, At, B0); PG8_BAR; PG8_SCHED;
            PG8_LDB(B1, 1, 1); PG8_STAGE(PG8_SB(1, 0), b3, voffB);
            PG8_BAR; PG8_WAIT_L(0); PG8_MMA(0, 1, At, B1); PG8_BAR;
            PG8_LDA(At, 1, 1); PG8_STAGE(PG8_SA(1, 0), a3, voffA);
            PG8_BAR; PG8_WAIT_L(0); PG8_MMA(1, 0, At, B0); PG8_BAR; PG8_SCHED;
            PG8_STAGE(PG8_SB(1, 1), b3 + hstep, voffB);
            PG8_WAIT_V(6); PG8_BAR; PG8_MMA(1, 1, At, B1); PG8_BAR;
        }
        E(acc, cur, wr, wc, fr, fq);
        if (!has_next) break;
#pragma unroll
        for (int a = 0; a < 2; ++a)
#pragma unroll
            for (int b = 0; b < 2; ++b)
#pragma unroll
                for (int m = 0; m < 4; ++m)
#pragma unroll
                    for (int n = 0; n < 2; ++n) acc[a][b][m][n] = (f32x4){0.f, 0.f, 0.f, 0.f};
        cur = nxt; cA = nA; cB = nB; ++ui;
    }
    PG8_WAIT_V(0);
    if (wr == 0) PG8_BAR;
    PG8_BAR;
#undef PG8_SA
#undef PG8_SB
#undef PG8_STAGE
#undef PG8_LDA
#undef PG8_LDB
#undef PG8_MMA
#undef PG8_WAIT_V
#undef PG8_WAIT_L
#undef PG8_BAR
#undef PG8_SCHED
}
}

__device__ __forceinline__ void st_bf8(bf16_t* p, const f32x4& a, const f32x4& b) {
    uint4 v; v.x = pack2(a[0], a[1]); v.y = pack2(a[2], a[3]); v.z = pack2(b[0], b[1]); v.w = pack2(b[2], b[3]);
    *(uint4*)p = v;
}
template <int ACT> __device__ __forceinline__ f32x4 act4(f32x4 v) {
    if (ACT == 1) { v[0] = siluf_(v[0]); v[1] = siluf_(v[1]); v[2] = siluf_(v[2]); v[3] = siluf_(v[3]); }
    if (ACT == 2) { v[0] = sigmoidf_(v[0]); v[1] = sigmoidf_(v[1]); v[2] = sigmoidf_(v[2]); v[3] = sigmoidf_(v[3]); }
    return v;
}

struct EpiIn {
    Params P;
    __device__ __forceinline__ void operator()(const f32x4 (&acc)[2][2][4][2], const pg8::Unit& u, int wr, int wc, int fr, int fq) const {
        char* ws = P.ws;
        const float* rt = (const float*)(ws + W_ROPE);
#pragma unroll
        for (int bj = 0; bj < 2; ++bj) {
            const int c32 = u.pn * 256 + bj * 128 + wc * 32;
            if (c32 >= NINP || c32 == 1376) continue;
            const int cl = 8 * fq;
#pragma unroll
            for (int ai = 0; ai < 2; ++ai)
#pragma unroll
                for (int m = 0; m < 4; ++m) {
                    const int tok = u.pm * 256 + ai * 128 + wr * 64 + m * 16 + fr;
                    const bool smp = tok >= NP;
                    const int st = tok - NP;
                    const int b = smp ? (st >> 6) : (tok >> 11);
                    const int t = smp ? (st & 63) : (tok & 2047);
                    const int pos = smp ? 1024 + t : t;
                    f32x4 v0 = acc[ai][bj][m][0], v1 = acc[ai][bj][m][1];
                    const bool ropeable = (c32 < 640) || (c32 >= 768 && c32 < 1344);
                    if (ropeable && (c32 & 63) == 0) {
                        f32x4 p0, p1;
#pragma unroll
                        for (int j = 0; j < 4; ++j) { p0[j] = __shfl_xor(v0[j], 16); p1[j] = __shfl_xor(v1[j], 16); }
                        if (fq < 2) {
                            const f32x4 c0 = *(const f32x4*)(rt + pos * 16), c1 = *(const f32x4*)(rt + pos * 16 + 4);
                            const f32x4 s0 = *(const f32x4*)(rt + pos * 16 + 8), s1 = *(const f32x4*)(rt + pos * 16 + 12);
                            const float sg = fq == 0 ? -1.f : 1.f;
#pragma unroll
                            for (int j = 0; j < 4; ++j) { v0[j] = v0[j] * c0[j] + sg * p0[j] * s0[j]; v1[j] = v1[j] * c1[j] + sg * p1[j] * s1[j]; }
                        }
                    }
                    if (c32 < 512) {
                        st_bf8((bf16_t*)(ws + W_Q) + (size_t)tok * 512 + c32 + cl, v0, v1);
                    } else if (c32 < 640) {
                        const int c = c32 - 512 + cl;
                        st_bf8((bf16_t*)(ws + (smp ? W_KS : W_KP)) + kf_index(b * 2 + (c >> 6), smp ? 34 : 64, pos, c & 63), v0, v1);
                        float* o = P.out + (smp ? O_KS + (size_t)st * 128 : O_KP + (size_t)tok * 128) + c;
                        *(f32x4*)o = v0; *(f32x4*)(o + 4) = v1;
                    } else if (c32 < 768) {
                        const int c = c32 - 640 + cl;
                        float* o = P.out + (smp ? O_VS + (size_t)st * 128 : O_VP + (size_t)tok * 128) + c;
                        *(f32x4*)o = v0; *(f32x4*)(o + 4) = v1;
                        bf16_t* vt = (bf16_t*)(ws + (smp ? W_VTS : W_VTP)) + vf_index(b * 2 + (c >> 6), smp ? 34 : 64, pos, c & 63);
#pragma unroll
                        for (int e = 0; e < 4; ++e) {
                            vt[e * 8] = f2bf(v0[e]);
                            vt[(4 + e) * 8] = f2bf(v1[e]);
                        }
                    } else if (c32 < 1280) {
                        st_bf8((bf16_t*)(ws + W_QI) + (size_t)tok * 512 + (c32 - 768) + cl, v0, v1);
                    } else if (c32 < 1344) {
                        const int c = c32 - 1280 + cl;
                        st_bf8((bf16_t*)(ws + (smp ? W_KIS : W_KIP)) + kf_index(b, smp ? 34 : 64, pos, c), v0, v1);
                        float* o = P.out + (smp ? O_KIS + (size_t)st * 64 : O_KIP + (size_t)tok * 64) + c;
                        *(f32x4*)o = v0; *(f32x4*)(o + 4) = v1;
                    } else if (c32 < 1376) {
                        if (fq == 0) {
                            const float sc = 0.35355339059327373f;
                            float* o = (float*)(ws + W_WI) + (size_t)tok * 8;
                            *(f32x4*)o = v0 * sc; *(f32x4*)(o + 4) = v1 * sc;
                        }
                    } else if (c32 < 1920) {
                        st_bf8((bf16_t*)(ws + W_GA) + (size_t)tok * 512 + (c32 - 1408) + cl, act4<1>(v0), act4<1>(v1));
                    } else if (c32 < 2432) {
                        st_bf8((bf16_t*)(ws + W_U) + (size_t)tok * 512 + (c32 - 1920) + cl, v0, v1);
                    } else if (c32 < 2944) {
                        st_bf8((bf16_t*)(ws + W_GS) + (size_t)tok * 512 + (c32 - 2432) + cl, act4<1>(v0), act4<1>(v1));
                    } else if (c32 < 3968) {
                        st_bf8((bf16_t*)(ws + W_MA) + (size_t)tok * 1024 + (c32 - 2944) + cl, act4<2>(v0), act4<2>(v1));
                    } else {
                        st_bf8((bf16_t*)(ws + W_MB) + (size_t)tok * 1024 + (c32 - 3968) + cl, act4<2>(v0), act4<2>(v1));
                    }
                }
        }
    }
};
__device__ __forceinline__ void phase2(const Params& P, char* smem) {
    pg8::StaticOrder S; S.init(NTOK, NINP2, (int)gridDim.x, (int)blockIdx.x);
    pg8::Gemm g{(const bf16_t*)(P.ws + W_H), (const bf16_t*)(P.ws + W_WTIN), NTOK, NINP2, 1024};
    EpiIn E{P};
    pg8::gemm_phase(( PG8_LAS unsigned char*)smem, g, S, E);
}

__device__ __forceinline__ void phase3(const Params& P, char* smem) {
    const int tid = threadIdx.x, lane = tid & 63, wave = tid >> 6, l32 = lane & 31, hh = lane >> 5;
    char* ws = P.ws;
    const bf16_t* U = (const bf16_t*)(ws + W_U);
    const bf16_t* WE = (const bf16_t*)(ws + W_WE);
    const float* A32 = (const float*)(ws + W_A32);
    float* HIN = (float*)(ws + W_E);
    for (int task = blockIdx.x * 8 + wave; task < 1024 + 64; task += gridDim.x * 8) {
        if (task < 1024) {
            const int sp = task & 1, g = (task >> 1) & 31, b = task >> 6;
            f32x16 acc[2][2];
#pragma unroll
            for (int rt = 0; rt < 2; ++rt)
#pragma unroll
                for (int c2 = 0; c2 < 2; ++c2)
#pragma unroll
                    for (int e = 0; e < 16; ++e) acc[rt][c2][e] = 0.f;
            const int sc0 = 32 * ((l32 >> 2) & 1) + 4 * (l32 >> 3) + (l32 & 3);
            const bf16_t* up0 = U + ((size_t)b * 2048 + (size_t)sc0 * 32) * 512 + g * 16 + 8 * hh;
            const bf16_t* up1 = up0 + (size_t)16 * 32 * 512;
            const bf16_t* wp = WE + ((size_t)g * 128 + sp * 32 + l32) * 512 + 8 * hh;
#pragma unroll 8
            for (int ks = 0; ks < 32; ++ks) {
                const bf16x8 a0 = *(const bf16x8*)(up0 + (size_t)ks * 512);
                const bf16x8 a1 = *(const bf16x8*)(up1 + (size_t)ks * 512);
#pragma unroll
                for (int c2 = 0; c2 < 2; ++c2) {
                    const bf16x8 bfr = *(const bf16x8*)(wp + (size_t)c2 * 64 * 512 + ks * 16);
                    acc[0][c2] = MFMA32(a0, bfr, acc[0][c2]);
                    acc[1][c2] = MFMA32(a1, bfr, acc[1][c2]);
                }
            }
            const int p = 32 * sp + l32, gp = g * 64 + p;
            const float a32r = A32[gp * 2], a32i = A32[gp * 2 + 1];
            float sr = 0.f, si = 0.f;
#pragma unroll
            for (int pass = 0; pass < 2; ++pass) {
                float hr = sr, hi = si;
#pragma unroll
                for (int rt = 0; rt < 2; ++rt)
#pragma unroll
                    for (int e = 0; e < 16; ++e) {
                        if (hh == pass) {
                            float* o = HIN + (((size_t)b * 64 + 32 * hh + 16 * rt + e) * 32 + g) * 128 + p;
                            o[0] = hr; o[64] = hi;
                        }
                        const float nr = a32r * hr - a32i * hi + acc[rt][0][e];
                        const float ni = a32r * hi + a32i * hr + acc[rt][1][e];
                        hr = nr; hi = ni;
                    }
                if (pass == 0) { sr = __shfl(hr, l32); si = __shfl(hi, l32); }
            }
        } else {
            const int sp = (task - 1024) & 1, g = (task - 1024) >> 1;
            f32x16 acc[2];
#pragma unroll
            for (int c2 = 0; c2 < 2; ++c2)
#pragma unroll
                for (int e = 0; e < 16; ++e) acc[c2][e] = 0.f;
            const bf16_t* up = U + ((size_t)NP + (size_t)l32 * 64) * 512 + g * 16 + 8 * hh;
            const bf16_t* wp = WE + ((size_t)g * 128 + sp * 32 + l32) * 512 + 8 * hh;
#pragma unroll 8
            for (int ks = 0; ks < 32; ++ks) {
                const bf16x8 a = *(const bf16x8*)(up + (size_t)ks * 512);
#pragma unroll
                for (int c2 = 0; c2 < 2; ++c2) {
                    const bf16x8 bfr = *(const bf16x8*)(wp + (size_t)c2 * 64 * 512 + ks * 16);
                    acc[c2] = MFMA32(a, bfr, acc[c2]);
                }
            }
            const int p = 32 * sp + l32, gp = g * 64 + p;
            const float a32r = A32[gp * 2], a32i = A32[gp * 2 + 1];
#pragma unroll
            for (int e = 0; e < 16; ++e) {
                const int bb = 8 * (e >> 2) + 4 * hh + (e & 3);
                const float h0r = P.st_re[(size_t)(bb * 32 + g) * 64 + p], h0i = P.st_im[(size_t)(bb * 32 + g) * 64 + p];
                float* o = HIN + (((size_t)1024 + bb) * 32 + g) * 128 + p;
                o[0] = a32r * h0r - a32i * h0i + acc[0][e];
                o[64] = a32r * h0i + a32i * h0r + acc[1][e];
            }
        }
    }
}

__device__ __forceinline__ void attn_task(const Params& P, int task, char* smem, bool dummy_out = false) {
    const int tid = threadIdx.x, lane = tid & 63, wave = tid >> 6, l32 = lane & 31, hh = lane >> 5;
    char* ws = P.ws;
    int tok0, L, n_adm;
    const bf16_t *KIb, *Kb, *Vtb;
    if (task < 2048) {
        const int qt = 127 - (task >> 4), b = task & 15;
        tok0 = b * 2048 + qt * 16; L = 2048; n_adm = ((qt >> 2) + 1) * 64;
        KIb = (const bf16_t*)(ws + W_KIP) + (size_t)b * 2048 * 64;
        Kb = (const bf16_t*)(ws + W_KP) + (size_t)b * 2048 * 128;
        Vtb = (const bf16_t*)(ws + W_VTP) + (size_t)b * 128 * 2048;
    } else {
        const int s = task - 2048, b = s >> 2, qt = s & 3;
        tok0 = NP + b * 64 + qt * 16; L = 1088; n_adm = 1088;
        KIb = (const bf16_t*)(ws + W_KIS) + (size_t)b * 1088 * 64;
        Kb = (const bf16_t*)(ws + W_KS) + (size_t)b * 1088 * 128;
        Vtb = (const bf16_t*)(ws + W_VTS) + (size_t)b * 128 * 1088;
    }
    const int ntile = n_adm >> 5;
    float* sc = (float*)smem;
    bf16x8 bq[4];
    {
        const bf16_t* Q = (const bf16_t*)(ws + W_Q);
        const int g3 = wave >> 2, qh3 = (wave >> 1) & 1;
        const int q3 = qh3 * 8 + (l32 >> 2), head3 = g3 * 4 + (l32 & 3);
#pragma unroll
        for (int ks = 0; ks < 4; ++ks) bq[ks] = *(const bf16x8*)(Q + (size_t)(tok0 + q3) * 512 + head3 * 64 + 32 * hh + 8 * ks);
    }
    {
        const bf16_t* QI = (const bf16_t*)(ws + W_QI);
        const float* WI = (const float*)(ws + W_WI);
        const int rg = wave >> 2, kq = wave & 3;
        bf16x8 aq[2][4];
        float wreg[2][16];
#pragma unroll
        for (int rt = 0; rt < 2; ++rt) {
            const int i = l32 >> 3, hR = (l32 >> 2) & 1, j = l32 & 3;
            const int q = rg * 8 + rt * 4 + 2 * hR + (i >> 1), head = 4 * (i & 1) + j;
#pragma unroll
            for (int ks = 0; ks < 4; ++ks) aq[rt][ks] = *(const bf16x8*)(QI + (size_t)(tok0 + q) * 512 + head * 64 + 32 * hh + 8 * ks);
#pragma unroll
            for (int qq = 0; qq < 2; ++qq) {
                const float* wp = WI + (size_t)(tok0 + rg * 8 + rt * 4 + 2 * hh + qq) * 8;
                const f32x4 w0 = *(const f32x4*)wp, w1 = *(const f32x4*)(wp + 4);
#pragma unroll
                for (int j = 0; j < 4; ++j) { wreg[rt][8 * qq + j] = w0[j] * 0.125f; wreg[rt][8 * qq + 4 + j] = w1[j] * 0.125f; }
            }
        }
        bf16x8 nb[4];
        if (kq < ntile) {
#pragma unroll
            for (int ks = 0; ks < 4; ++ks) nb[ks] = *(const bf16x8*)(KIb + ((size_t)(kq * 4 + ks) * 64 + lane) * 8);
        }
        for (int kt = kq; kt < ntile; kt += 4) {
            const int key = kt * 32 + l32;
            bf16x8 bk[4];
#pragma unroll
            for (int ks = 0; ks < 4; ++ks) bk[ks] = nb[ks];
            if (kt + 4 < ntile) {
#pragma unroll
                for (int ks = 0; ks < 4; ++ks) nb[ks] = *(const bf16x8*)(KIb + ((size_t)((kt + 4) * 4 + ks) * 64 + lane) * 8);
            }
#pragma unroll
            for (int rt = 0; rt < 2; ++rt) {
                f32x16 s;
#pragma unroll
                for (int e = 0; e < 16; ++e) s[e] = 0.f;
#pragma unroll
                for (int ks = 0; ks < 4; ++ks) s = MFMA32(aq[rt][ks], bk[ks], s);
                float s0 = 0.f, s1 = 0.f;
#pragma unroll
                for (int e = 0; e < 8; ++e) {
                    s0 += wreg[rt][e] * fmaxf(s[e], 0.f);
                    s1 += wreg[rt][8 + e] * fmaxf(s[8 + e], 0.f);
                }
                const int q0 = rg * 8 + rt * 4 + 2 * hh;
                sc[q0 * SCLD + key] = s0;
                sc[(q0 + 1) * SCLD + key] = s1;
            }
        }
    }
    __syncthreads();
    {
        const int nv = n_adm >> 6;
        const int qa = wave * 2;
        float v[2][32];
#pragma unroll
        for (int i = 0; i < 32; ++i) {
            v[0][i] = (i < nv) ? sc[qa * SCLD + lane + 64 * i] : -3.0e38f;
            v[1][i] = (i < nv) ? sc[(qa + 1) * SCLD + lane + 64 * i] : -3.0e38f;
        }
        float thr[2] = {-3.0e38f, -3.0e38f};
        if (n_adm > 256) {
#define COUNT_GE(Q, T, OUT) do { int _c = 0; _Pragma("unroll") for (int i = 0; i < 32; ++i) _c += (v[Q][i] >= (T)) ? 1 : 0; \
        int _t = 0; _Pragma("unroll") for (int bb = 0; bb < 6; ++bb) _t += __popcll(__ballot((_c >> bb) & 1)) << bb; (OUT) = _t; } while (0)
            float lo[2], hi[2], mid[2], tprev[2], dens[2];
            int clo[2], chi[2], cprev[2];
            bool done[2];
            const float fn = (float)n_adm;
            const float pq = 256.f / fn;
            const float pt = pq <= 0.5f ? pq : 1.f - pq;
            const float tt = sqrtf(-2.f * __logf(pt));
            float z = tt - (2.30753f + 0.27061f * tt) / (1.f + 0.99229f * tt + 0.04481f * tt * tt);
            if (pq > 0.5f) z = -z;
            const float dz = fn * __expf(-0.5f * z * z) * 0.39894228f;
#pragma unroll
            for (int qq = 0; qq < 2; ++qq) {
                float mx = -3.0e38f, mn = 3.0e38f, s1 = 0.f, s2 = 0.f;
#pragma unroll
                for (int i = 0; i < 32; ++i) {
                    const bool ok = v[qq][i] > -1.0e38f;
                    const float x = ok ? v[qq][i] : 0.f;
                    mx = fmaxf(mx, v[qq][i]); mn = fminf(mn, ok ? v[qq][i] : 3.0e38f);
                    s1 += x; s2 += x * x;
                }
#pragma unroll
                for (int o = 32; o >= 1; o >>= 1) {
                    mx = fmaxf(mx, __shfl_xor(mx, o)); mn = fminf(mn, __shfl_xor(mn, o));
                    s1 += __shfl_xor(s1, o); s2 += __shfl_xor(s2, o);
                }
                int c;
                COUNT_GE(qq, mx, c);
                const float mean = s1 * frcp(fn);
                const float sd = sqrtf(fmaxf(s2 * frcp(fn) - mean * mean, 1e-20f));
                lo[qq] = mn; hi[qq] = mx; clo[qq] = n_adm; chi[qq] = c;
                mid[qq] = mean + z * sd; tprev[qq] = 0.f; cprev[qq] = 256;
                dens[qq] = dz * frcp(sd);
                done[qq] = (c >= 256);
                thr[qq] = done[qq] ? mx : mn;
            }
            for (int it = 0; it < 64 && !(done[0] && done[1]); ++it) {
#pragma unroll
                for (int qq = 0; qq < 2; ++qq) {
                    const float interp = lo[qq] + (hi[qq] - lo[qq]) * ((float)(clo[qq] - 256) * frcp((float)(clo[qq] - chi[qq])));
                    const float bis = 0.5f * (lo[qq] + hi[qq]);
                    float md = mid[qq];
                    if (it == 1) { md = tprev[qq] + (float)(cprev[qq] - 256) * frcp(dens[qq]); if (!(md > lo[qq] && md < hi[qq])) md = interp; }
                    else if (it >= 2) md = (it % 3 != 0) ? interp : bis;
                    if (!(md > lo[qq] && md < hi[qq])) md = bis;
                    mid[qq] = md;
                }
                int cc0 = 0, cc1 = 0;
                COUNT_GE(0, mid[0], cc0);
                COUNT_GE(1, mid[1], cc1);
#pragma unroll
                for (int qq = 0; qq < 2; ++qq) {
                    const int cc = qq ? cc1 : cc0;
                    if (!done[qq]) {
                        const float md = mid[qq];
                        if (!(md > lo[qq] && md < hi[qq])) { thr[qq] = lo[qq]; done[qq] = true; }
                        else if (cc == 256) { thr[qq] = md; done[qq] = true; }
                        else {
                            tprev[qq] = md; cprev[qq] = cc;
                            if (cc > 256) { lo[qq] = md; clo[qq] = cc; } else { hi[qq] = md; chi[qq] = cc; }
                            thr[qq] = lo[qq];
                        }
                    }
                }
            }
#undef COUNT_GE
        }
#pragma unroll
        for (int i = 0; i < 32; ++i)
            if (i < nv) {
                sc[qa * SCLD + lane + 64 * i] = (v[0][i] >= thr[0]) ? 0.f : -1.0e30f;
                sc[(qa + 1) * SCLD + lane + 64 * i] = (v[1][i] >= thr[1]) ? 0.f : -1.0e30f;
            }
    }
    __syncthreads();
    {
        const int g = wave >> 2, qh = (wave >> 1) & 1, ksp = wave & 1;
        const int q = qh * 8 + (l32 >> 2), head = g * 4 + (l32 & 3);
        f32x16 o[2];
#pragma unroll
        for (int e = 0; e < 16; ++e) { o[0][e] = 0.f; o[1][e] = 0.f; }
        float m = -3.0e38f, lsum = 0.f;
        const float c1 = 0.125f * 1.44269504f;
        const bf16_t* Kg = Kb + (size_t)g * L * 64;
        const bf16_t* Vg = Vtb + (size_t)g * L * 64;
        bf16x8 nk[4], nv[2][2];
        if (ksp < ntile) {
#pragma unroll
            for (int ks = 0; ks < 4; ++ks) nk[ks] = *(const bf16x8*)(Kg + ((size_t)(ksp * 4 + ks) * 64 + lane) * 8);
#pragma unroll
            for (int s2 = 0; s2 < 2; ++s2)
#pragma unroll
                for (int dt = 0; dt < 2; ++dt) nv[dt][s2] = *(const bf16x8*)(Vg + ((size_t)((ksp * 2 + s2) * 2 + dt) * 64 + lane) * 8);
        }
        for (int kt = ksp; kt < ntile; kt += 2) {
            bf16x8 ak[4], av[2][2];
#pragma unroll
            for (int ks = 0; ks < 4; ++ks) ak[ks] = nk[ks];
#pragma unroll
            for (int s2 = 0; s2 < 2; ++s2)
#pragma unroll
                for (int dt = 0; dt < 2; ++dt) av[dt][s2] = nv[dt][s2];
            if (kt + 2 < ntile) {
                const int kn = kt + 2;
#pragma unroll
                for (int ks = 0; ks < 4; ++ks) nk[ks] = *(const bf16x8*)(Kg + ((size_t)(kn * 4 + ks) * 64 + lane) * 8);
#pragma unroll
                for (int s2 = 0; s2 < 2; ++s2)
#pragma unroll
                    for (int dt = 0; dt < 2; ++dt) nv[dt][s2] = *(const bf16x8*)(Vg + ((size_t)((kn * 2 + s2) * 2 + dt) * 64 + lane) * 8);
            }
            f32x16 s;
#pragma unroll
            for (int e = 0; e < 16; ++e) s[e] = 0.f;
#pragma unroll
            for (int ks = 0; ks < 4; ++ks) s = MFMA32(ak[ks], bq[ks], s);
            f32x2 t2[8];
#pragma unroll
            for (int i = 0; i < 4; ++i) {
                const f32x4 bi = *(const f32x4*)(sc + q * SCLD + kt * 32 + 8 * i + 4 * hh);
                t2[2 * i] = (f32x2){s[4 * i], s[4 * i + 1]} * c1 + (f32x2){bi[0], bi[1]};
                t2[2 * i + 1] = (f32x2){s[4 * i + 2], s[4 * i + 3]} * c1 + (f32x2){bi[2], bi[3]};
            }
            float mloc = fmaxf(fmaxf(t2[0].x, t2[0].y), fmaxf(t2[1].x, t2[1].y));
#pragma unroll
            for (int i = 2; i < 8; i += 2) mloc = fmaxf(mloc, fmaxf(fmaxf(t2[i].x, t2[i].y), fmaxf(t2[i + 1].x, t2[i + 1].y)));
            mloc = fmaxf(mloc, __shfl_xor(mloc, 32));
            if (__ballot(mloc > m + 8.f) != 0ull) {
                const float mnew = (mloc > m + 8.f) ? mloc : m;
                const float alpha = fexp2(m - mnew);
                m = mnew;
                lsum *= alpha;
                const f32x2 al2 = (f32x2){alpha, alpha};
#pragma unroll
                for (int e = 0; e < 16; e += 2) {
                    f32x2 a0 = (f32x2){o[0][e], o[0][e + 1]} * al2, a1 = (f32x2){o[1][e], o[1][e + 1]} * al2;
                    o[0][e] = a0.x; o[0][e + 1] = a0.y; o[1][e] = a1.x; o[1][e + 1] = a1.y;
                }
            }
            const f32x2 m2 = (f32x2){m, m};
            f32x2 ps2 = (f32x2){0.f, 0.f};
#pragma unroll
            for (int i = 0; i < 8; ++i) {
                const f32x2 d = t2[i] - m2;
                f32x2 pe; pe.x = fexp2(d.x); pe.y = fexp2(d.y);
                ps2 += pe;
                s[2 * i] = pe.x; s[2 * i + 1] = pe.y;
            }
            lsum += ps2.x + ps2.y;
            bf16x8 pb[2];
#pragma unroll
            for (int s2 = 0; s2 < 2; ++s2) {
                union { uint4 u; bf16x8 v; } cv;
                cv.u = make_uint4(pack2(s[8 * s2], s[8 * s2 + 1]), pack2(s[8 * s2 + 2], s[8 * s2 + 3]),
                                  pack2(s[8 * s2 + 4], s[8 * s2 + 5]), pack2(s[8 * s2 + 6], s[8 * s2 + 7]));
                pb[s2] = cv.v;
            }
#pragma unroll
            for (int dt = 0; dt < 2; ++dt)
#pragma unroll
                for (int s2 = 0; s2 < 2; ++s2) o[dt] = MFMA32(av[dt][s2], pb[s2], o[dt]);
        }
        lsum += __shfl_xor(lsum, 32);
        __syncthreads();
        float* cb = (float*)smem + (wave >> 1) * (64 * 34);
        if (ksp == 1) {
            cb[lane] = m; cb[64 + lane] = lsum;
#pragma unroll
            for (int dt = 0; dt < 2; ++dt)
#pragma unroll
                for (int e = 0; e < 16; ++e) cb[(2 + dt * 16 + e) * 64 + lane] = o[dt][e];
        }
        __syncthreads();
        if (ksp == 0) {
            const float m1 = cb[lane], l1 = cb[64 + lane];
            const float mm = fmaxf(m, m1);
            const float a0 = fexp2(m - mm), a1 = fexp2(m1 - mm);
            const float inv = 1.f / (lsum * a0 + l1 * a1);
            bf16_t* GA = (bf16_t*)(ws + W_GA);
#pragma unroll
            for (int dt = 0; dt < 2; ++dt)
#pragma unroll
                for (int i = 0; i < 4; ++i) {
                    bf16_t* gp = GA + (size_t)(tok0 + q) * 512 + head * 64 + dt * 32 + 8 * i + 4 * hh;
                    const uint2 gv = *(const uint2*)gp;
                    float r[4];
#pragma unroll
                    for (int j = 0; j < 4; ++j) r[j] = (o[dt][4 * i + j] * a0 + cb[(2 + dt * 16 + 4 * i + j) * 64 + lane] * a1) * inv;
                    bf16_t* op = dummy_out ? (bf16_t*)(ws + W_H + (size_t)NTOK * 1024) + (gp - GA) : gp;
                    st_bf4(op, r[0] * bflo(gv.x), r[1] * bfhi(gv.x), r[2] * bflo(gv.y), r[3] * bfhi(gv.y));
                }
        }
        __syncthreads();
    }
}

__device__ __forceinline__ void ssm_task(const Params& P, int task, char* hs  ) {
    const int lane = threadIdx.x & 63, l32 = lane & 31, hh = lane >> 5;
    char* ws = P.ws;
    const bf16_t* U = (const bf16_t*)(ws + W_U);
    const float* E = (const float*)(ws + W_E);
    const float* A1 = (const float*)(ws + W_A1);
    bool smp; int b, g, j64, tb;
    if (task < 16384) { smp = false; g = task & 31; j64 = (task >> 5) & 31; b = task >> 10; tb = b * 2048 + j64 * 64; }
    else { const int s = task - 16384; smp = true; g = s & 31; b = s >> 5; j64 = 0; tb = NP + b * 64; }
    f32x16 bu[2][4];
    {
        bf16x8 au[2], bb[4];
#pragma unroll
        for (int rt = 0; rt < 2; ++rt) {
            const int tau = 32 * ((l32 >> 2) & 1) + 16 * rt + 4 * (l32 >> 3) + (l32 & 3);
            au[rt] = *(const bf16x8*)(U + (size_t)(tb + tau) * 512 + g * 16 + 8 * hh);
        }
        const bf16_t* Bt = (const bf16_t*)(ws + W_BT);
#pragma unroll
        for (int ct = 0; ct < 4; ++ct) bb[ct] = *(const bf16x8*)(Bt + ((size_t)g * 128 + ct * 32 + l32) * 16 + 8 * hh);
        f32x16 z;
#pragma unroll
        for (int e = 0; e < 16; ++e) z[e] = 0.f;
#pragma unroll
        for (int rt = 0; rt < 2; ++rt)
#pragma unroll
            for (int ct = 0; ct < 4; ++ct) bu[rt][ct] = MFMA32(au[rt], bb[ct], z);
    }
    float cr[2], ci[2];
#pragma unroll
    for (int sp = 0; sp < 2; ++sp) {
        const int p = 32 * sp + l32;
        if (!smp) {
            const float* ep = E + (((size_t)b * 64 + 2 * j64 + hh) * 32 + g) * 128 + p;
            cr[sp] = ep[0]; ci[sp] = ep[64];
        } else {
            const float* ep = E + (((size_t)1024 + b) * 32 + g) * 128 + p;
            const float* h0r = P.st_re + (size_t)(b * 32 + g) * 64 + p;
            const float* h0i = P.st_im + (size_t)(b * 32 + g) * 64 + p;
            cr[sp] = hh ? ep[0] : h0r[0];
            ci[sp] = hh ? ep[64] : h0i[0];
        }
    }
#pragma unroll
    for (int sp = 0; sp < 2; ++sp) {
        const int p = 32 * sp + l32, gp = g * 64 + p;
        const float ar = A1[gp * 2], ai = A1[gp * 2 + 1];
        float hr = cr[sp], hi = ci[sp];
#pragma unroll
        for (int rt = 0; rt < 2; ++rt)
#pragma unroll
            for (int e = 0; e < 16; ++e) {
                const float nr = ar * hr - ai * hi + bu[rt][sp][e];
                const float ni = ar * hi + ai * hr + bu[rt][sp + 2][e];
                hr = nr; hi = ni;
                bu[rt][sp][e] = hr; bu[rt][sp + 2][e] = hi;
            }
        if (hh == 1 && (smp || j64 == 31)) {
            float* ore = P.out + (smp ? O_HRS : O_HRP) + (size_t)(b * 32 + g) * 64 + p;
            float* oim = P.out + (smp ? O_HIS : O_HIP) + (size_t)(b * 32 + g) * 64 + p;
            *ore = hr; *oim = hi;
        }
    }
    asm volatile("s_waitcnt lgkmcnt(0)" ::: "memory");
#pragma unroll
    for (int rt = 0; rt < 2; ++rt)
#pragma unroll
        for (int e = 0; e < 16; ++e) {
            const int tau = 32 * hh + 16 * rt + e;
            uint2 v; v.x = pack2(bu[rt][0][e], bu[rt][1][e]); v.y = pack2(bu[rt][2][e], bu[rt][3][e]);
            *(uint2*)(hs + tau * 272 + l32 * 8) = v;
        }
    asm volatile("s_waitcnt lgkmcnt(0)" ::: "memory");
    __builtin_amdgcn_wave_barrier();
    {
        const bf16_t* Cc = (const bf16_t*)(ws + W_CC);
        bf16_t* YG = (bf16_t*)(ws + W_H);
        const int l16 = lane & 15, lq = lane >> 4;
        bf16x8 cc[4];
#pragma unroll
        for (int ks = 0; ks < 4; ++ks) cc[ks] = *(const bf16x8*)(Cc + ((size_t)g * 16 + l16) * 128 + 32 * ks + 8 * lq);
        const int ch = g * 16 + l16;
        const float dsk = P.d_skip[ch];
#pragma unroll
        for (int r16 = 0; r16 < 4; ++r16) {
            f32x4 y = {0.f, 0.f, 0.f, 0.f};
#pragma unroll
            for (int ks = 0; ks < 4; ++ks) {
                const bf16x8 a = *(const bf16x8*)(hs + (16 * r16 + l16) * 272 + (32 * ks + 8 * lq) * 2);
                y = MFMA16(a, cc[ks], y);
            }
#pragma unroll
            for (int j = 0; j < 4; ++j) {
                const size_t idx = (size_t)(tb + 16 * r16 + 4 * lq + j) * 512 + ch;
                const float u = bf2f(U[idx]);
                YG[idx] = f2bf(geluf_(y[j] + dsk * u));
            }
        }
    }
    asm volatile("s_waitcnt lgkmcnt(0)" ::: "memory");
    __builtin_amdgcn_wave_barrier();
}

__device__ __forceinline__ void phase4(const Params& P, char* smem, bool dummy_out = false) {
    const int tid = threadIdx.x, lane = tid & 63, wave = tid >> 6;
    unsigned* cnt = (unsigned*)(P.ws + W_CNT);
    int* slot = (int*)(smem + 16 * SCLD * 4);
    int pend = 0;
    if (tid == 0) pend = (int)atomicAdd(cnt + 0, 1u);
    for (;;) {
        if (tid == 0) *slot = pend;
        __syncthreads();
        const int task = *slot;
        if (task >= 2048 + 128) break;
        if (tid == 0) pend = (int)atomicAdd(cnt + 0, 1u);
        attn_task(P, task, smem, dummy_out);
    }
    __syncthreads();
    char* hs = smem + wave * 17408;
    for (;;) {
        int chunk = 0;
        if (lane == 0) chunk = (int)atomicAdd(cnt + 16, 1u);
        chunk = __shfl(chunk, 0);
        if (chunk >= (16384 + 1024) / 2) break;
        for (int i = 0; i < 2; ++i) ssm_task(P, chunk * 2 + i, hs);
    }
}

struct EpiGlu {
    Params P;
    __device__ __forceinline__ void operator()(const f32x4 (&acc)[2][2][4][2], const pg8::Unit& u, int wr, int wc, int fr, int fq) const {
        const bf16_t* GS = (const bf16_t*)(P.ws + W_GS);
        bf16_t* T2 = (bf16_t*)(P.ws + W_U);
        uint2 gv[2][4][2];
#pragma unroll
        for (int ai = 0; ai < 2; ++ai)
#pragma unroll
            for (int m = 0; m < 4; ++m)
#pragma unroll
                for (int bj = 0; bj < 2; ++bj) {
                    const int tok = u.pm * 256 + ai * 128 + wr * 64 + m * 16 + fr;
                    gv[ai][m][bj] = *(const uint2*)(GS + (size_t)tok * 512 + u.pn * 128 + bj * 64 + wc * 16 + 4 * fq);
                }
#pragma unroll
        for (int ai = 0; ai < 2; ++ai)
#pragma unroll
            for (int m = 0; m < 4; ++m)
#pragma unroll
                for (int bj = 0; bj < 2; ++bj) {
                    const int tok = u.pm * 256 + ai * 128 + wr * 64 + m * 16 + fr;
                    const size_t idx = (size_t)tok * 512 + u.pn * 128 + bj * 64 + wc * 16 + 4 * fq;
                    const uint2 g = gv[ai][m][bj];
                    const f32x4 va = acc[ai][bj][m][0], ga = act4<2>(acc[ai][bj][m][1]);
                    st_bf4(T2 + idx, va[0] * ga[0] * bflo(g.x), va[1] * ga[1] * bfhi(g.x), va[2] * ga[2] * bflo(g.y), va[3] * ga[3] * bfhi(g.y));
                }
    }
};
__device__ __forceinline__ void phase5(const Params& P, char* smem);
template <int PART>
struct EpiMerge {
    Params P;
    __device__ __forceinline__ void operator()(const f32x4 (&acc)[2][2][4][2], const pg8::Unit& u, int wr, int wc, int fr, int fq) const {
        const bf16_t* MX = (const bf16_t*)(P.ws + (PART == 0 ? W_MA : W_MB));
        bf16_t* MG = (bf16_t*)(P.ws + W_Q);
#pragma unroll
        for (int ai = 0; ai < 2; ++ai) {
            uint4 mv[4][2], pv[4][2];
#pragma unroll
            for (int m = 0; m < 4; ++m)
#pragma unroll
                for (int bj = 0; bj < 2; ++bj) {
                    const int tok = u.pm * 256 + ai * 128 + wr * 64 + m * 16 + fr;
                    const size_t idx = (size_t)tok * 1024 + u.pn * 256 + bj * 128 + wc * 32 + 8 * fq;
                    mv[m][bj] = *(const uint4*)(MX + idx);
                    if (PART == 1) pv[m][bj] = *(const uint4*)(MG + idx);
                }
#pragma unroll
            for (int m = 0; m < 4; ++m)
#pragma unroll
                for (int bj = 0; bj < 2; ++bj) {
                    const int tok = u.pm * 256 + ai * 128 + wr * 64 + m * 16 + fr;
                    const size_t idx = (size_t)tok * 1024 + u.pn * 256 + bj * 128 + wc * 32 + 8 * fq;
                    const uint4 a = mv[m][bj];
                    f32x4 r0 = acc[ai][bj][m][0], r1 = acc[ai][bj][m][1];
                    r0[0] *= bflo(a.x); r0[1] *= bfhi(a.x); r0[2] *= bflo(a.y); r0[3] *= bfhi(a.y);
                    r1[0] *= bflo(a.z); r1[1] *= bfhi(a.z); r1[2] *= bflo(a.w); r1[3] *= bfhi(a.w);
                    if (PART == 1) {
                        const uint4 b = pv[m][bj];
                        r0[0] += bflo(b.x); r0[1] += bfhi(b.x); r0[2] += bflo(b.y); r0[3] += bfhi(b.y);
                        r1[0] += bflo(b.z); r1[1] += bfhi(b.z); r1[2] += bflo(b.w); r1[3] += bfhi(b.w);
                    }
                    st_bf8(MG + idx, r0, r1);
                }
        }
    }
};
__device__ __forceinline__ void phase5(const Params& P, char* smem) {
    {
        pg8::StaticOrder S; S.init(NTOK, 1024, (int)gridDim.x, (int)blockIdx.x);
        pg8::Gemm g{(const bf16_t*)(P.ws + W_H), (const bf16_t*)(P.ws + W_WTGLU), NTOK, 1024, 512};
        EpiGlu E{P};
        pg8::gemm_phase((PG8_LAS unsigned char*)smem, g, S, E);
    }
    {
        pg8::StaticOrder S; S.init(NTOK, 1024, (int)gridDim.x, (int)(gridDim.x - 1 - blockIdx.x));
        pg8::Gemm g{(const bf16_t*)(P.ws + W_GA), (const bf16_t*)(P.ws + W_WTAP), NTOK, 1024, 512};
        EpiMerge<0> E{P};
        pg8::gemm_phase((PG8_LAS unsigned char*)smem, g, S, E);
    }
}
__device__ __forceinline__ void phase6(const Params& P, char* smem) {
    pg8::StaticOrder S; S.init(NTOK, 1024, (int)gridDim.x, (int)blockIdx.x);
    pg8::Gemm g{(const bf16_t*)(P.ws + W_U), (const bf16_t*)(P.ws + W_WTSP), NTOK, 1024, 512};
    EpiMerge<1> E{P};
    pg8::gemm_phase((PG8_LAS unsigned char*)smem, g, S, E);
}

struct EpiOut {
    Params P;
    __device__ __forceinline__ void operator()(const f32x4 (&acc)[2][2][4][2], const pg8::Unit& u, int wr, int wc, int fr, int fq) const {
        const float* modf = (const float*)(P.ws + W_MODF);
#pragma unroll
        for (int ai = 0; ai < 2; ++ai) {
            f32x4 xv[4][2][2];
#pragma unroll
            for (int m = 0; m < 4; ++m) {
                const float* xr = xrow(P, u.pm * 256 + ai * 128 + wr * 64 + m * 16 + fr);
#pragma unroll
                for (int bj = 0; bj < 2; ++bj) {
                    const int n = u.pn * 256 + bj * 128 + wc * 32 + 8 * fq;
                    xv[m][bj][0] = *(const f32x4*)(xr + n); xv[m][bj][1] = *(const f32x4*)(xr + n + 4);
                }
            }
#pragma unroll
            for (int m = 0; m < 4; ++m) {
                const int tok = u.pm * 256 + ai * 128 + wr * 64 + m * 16 + fr;
                const float* gate = modf + (size_t)modrow(tok) * 3072 + 2048;
#pragma unroll
                for (int bj = 0; bj < 2; ++bj) {
                    const int n = u.pn * 256 + bj * 128 + wc * 32 + 8 * fq;
                    const f32x4 g0 = *(const f32x4*)(gate + n), g1 = *(const f32x4*)(gate + n + 4);
                    float* o = P.out + O_Y + (size_t)tok * 1024 + n;
                    *(f32x4*)o = xv[m][bj][0] + g0 * acc[ai][bj][m][0];
                    *(f32x4*)(o + 4) = xv[m][bj][1] + g1 * acc[ai][bj][m][1];
                }
            }
        }
    }
};
__device__ __forceinline__ void phase7(const Params& P, char* smem) {
    pg8::StaticOrder S; S.init(NTOK, 1024, (int)gridDim.x, (int)blockIdx.x);
    pg8::Gemm g{(const bf16_t*)(P.ws + W_Q), (const bf16_t*)(P.ws + W_WTOUT), NTOK, 1024, 1024};
    EpiOut E{P};
    pg8::gemm_phase((PG8_LAS unsigned char*)smem, g, S, E);
}

__device__ __forceinline__ void phase8(const Params& P, char* smem) {
    const int lane = threadIdx.x & 63, wave = threadIdx.x >> 6;
    for (int tok0 = (blockIdx.x * 8 + wave) * 2; tok0 < NTOK; tok0 += gridDim.x * 16) {
        float4 v[2][4];
#pragma unroll
        for (int r = 0; r < 2; ++r)
#pragma unroll
            for (int i = 0; i < 4; ++i) v[r][i] = *(const float4*)(P.out + O_Y + (size_t)(tok0 + r) * 1024 + 4 * lane + 256 * i);
        float4 g4[4];
#pragma unroll
        for (int i = 0; i < 4; ++i) g4[i] = *(const float4*)(P.g_final + 4 * lane + 256 * i);
#pragma unroll
        for (int r = 0; r < 2; ++r) {
            float* y = P.out + O_Y + (size_t)(tok0 + r) * 1024;
            float ss = 0.f;
#pragma unroll
            for (int i = 0; i < 4; ++i) ss += v[r][i].x * v[r][i].x + v[r][i].y * v[r][i].y + v[r][i].z * v[r][i].z + v[r][i].w * v[r][i].w;
#pragma unroll
            for (int o = 32; o >= 1; o >>= 1) ss += __shfl_xor(ss, o);
            const float rinv = rsqrtf(ss * (1.f / 1024.f) + 1e-6f);
#pragma unroll
            for (int i = 0; i < 4; ++i)
                *(float4*)(y + 4 * lane + 256 * i) = make_float4(v[r][i].x * rinv * g4[i].x, v[r][i].y * rinv * g4[i].y, v[r][i].z * rinv * g4[i].z, v[r][i].w * rinv * g4[i].w);
        }
    }
}

#define XB_TMO      128
#define XB_XCNT(j)  (256  + 64 * (j))
#define XB_XSUB(j)  (1280 + 64 * (j))
#define XB_XGEN(j)  (2304 + 64 * (j))
#define XB_TOP      3328
#define XB_TOPGEN   3392
#define XCD_BAR_WORDS 3456
#define XB_SPIN_CAP (1u << 18)
#define LAS __attribute__((address_space(3)))
__device__ __forceinline__ unsigned xb_ld(unsigned* p)              { return __hip_atomic_load(p, __ATOMIC_RELAXED, __HIP_MEMORY_SCOPE_AGENT); }
__device__ __forceinline__ unsigned xb_add(unsigned* p, unsigned v) { return __hip_atomic_fetch_add(p, v, __ATOMIC_RELAXED, __HIP_MEMORY_SCOPE_AGENT); }
__device__ __forceinline__ unsigned xb_xcc_id() { return (unsigned)__builtin_amdgcn_s_getreg((3 << 11) | 20) & 0xFu; }
#define XB_SPIN(cond, bar) do { unsigned _sp = 0; while (cond) { __builtin_amdgcn_s_sleep(1); \
    if ((++_sp & 255u) == 0u) { if (xb_ld(&(bar)[XB_TMO])) break; if (_sp > XB_SPIN_CAP) { atomicAdd(&(bar)[XB_TMO], 1u); break; } } } } while (0)
struct XcdBarrier { unsigned* bar; unsigned x; volatile LAS unsigned* st; };
__device__ __forceinline__ XcdBarrier xcd_barrier_post(unsigned* bar, volatile LAS unsigned* st) {
    XcdBarrier b; b.bar = bar; b.x = xb_xcc_id(); b.st = st;
    if (threadIdx.x == 0) (void)xb_add(&bar[XB_XCNT(b.x)], 1u);
    return b;
}
__device__ __forceinline__ void xcd_barrier_complete(unsigned* bar, unsigned x, unsigned& nloc, unsigned& nx) {
    const unsigned G = gridDim.x * gridDim.y * gridDim.z;
    unsigned sum, cnt, mine, sp = 0u;
    for (;;) {
        sum = 0u; cnt = 0u; mine = 0u;
#pragma unroll
        for (unsigned j = 0; j < 16; ++j) { const unsigned c = xb_ld(&bar[XB_XCNT(j)]); sum += c; cnt += (c > 0u) ? 1u : 0u; mine = (j == x) ? c : mine; }
        if (sum == G) break;
        __builtin_amdgcn_s_sleep(1);
        if ((++sp & 255u) == 0u) { if (xb_ld(&bar[XB_TMO])) break; if (sp > XB_SPIN_CAP) { atomicAdd(&bar[XB_TMO], 1u); break; } }
    }
    nloc = mine > 0u ? mine : 1u; nx = cnt > 0u ? cnt : 1u;
}
__device__ __forceinline__ void xcd_barrier(const XcdBarrier& b) {
    asm volatile("s_waitcnt vmcnt(0)" ::: "memory");
    __syncthreads();
    if (threadIdx.x == 0) {
        unsigned* bar = b.bar;
        __builtin_amdgcn_s_waitcnt(0);
        unsigned nloc = b.st[0], nx = b.st[1];
        if (nloc == 0u) { xcd_barrier_complete(bar, b.x, nloc, nx); b.st[0] = nloc; b.st[1] = nx; }
        const unsigned old = xb_add(&bar[XB_XSUB(b.x)], 1u);
        const unsigned gen = old / nloc;
        if (old + 1u == (gen + 1u) * nloc) {
            __builtin_amdgcn_fence(__ATOMIC_RELEASE, "agent");
            asm volatile("s_waitcnt vmcnt(0)" ::: "memory");
            const unsigned og = xb_add(&bar[XB_TOP], 1u);
            const unsigned tg = og / nx;
            if (og + 1u == (tg + 1u) * nx) xb_add(&bar[XB_TOPGEN], 1u);
            else XB_SPIN(xb_ld(&bar[XB_TOPGEN]) == tg, bar);
            __builtin_amdgcn_fence(__ATOMIC_ACQUIRE, "agent");
            xb_add(&bar[XB_XGEN(b.x)], 1u);
            asm volatile("s_waitcnt vmcnt(0)" ::: "memory");
        } else {
            XB_SPIN(xb_ld(&bar[XB_XGEN(b.x)]) == gen, bar);
            __builtin_amdgcn_fence(__ATOMIC_ACQUIRE, "agent");
            asm volatile("s_waitcnt vmcnt(0)" ::: "memory");
        }
    }
    __syncthreads();
}

extern __shared__ __attribute__((aligned(16))) char dyn_smem[];

#ifndef REP2
#define REP2 0
#endif
#ifndef REP4
#define REP4 0
#endif
#ifndef REPSYNC
#define REPSYNC 1
#endif
#define GSYNC() xcd_barrier(xb)
__global__ void __launch_bounds__(NTHREADS) mega_kernel(Params P) {
    cg::grid_group grid = cg::this_grid();
    volatile LAS unsigned* xst = (volatile LAS unsigned*)(dyn_smem + SMEM_BYTES - 16);
    if (threadIdx.x == 0) { xst[0] = 0u; xst[1] = 0u; }
    __syncthreads();
    XcdBarrier xb = xcd_barrier_post((unsigned*)(P.ws + W_BAR), xst);
    if (P.out == nullptr) grid.sync();
    phase0(P, dyn_smem); GSYNC();
    phase1(P, dyn_smem); GSYNC();
    phase2(P, dyn_smem); GSYNC();
#if REP2
    phase2(P, dyn_smem); GSYNC();
#endif
    phase3(P, dyn_smem); GSYNC();
#if REP4
    phase4(P, dyn_smem, true); GSYNC();
    if (blockIdx.x == 0 && threadIdx.x < 64) ((unsigned*)(P.ws + W_CNT))[threadIdx.x] = 0u;
    GSYNC();
#endif
    phase4(P, dyn_smem); GSYNC();
    phase5(P, dyn_smem); GSYNC();
    phase6(P, dyn_smem); GSYNC();
    phase7(P, dyn_smem); GSYNC();
    phase8(P, dyn_smem);
}

template <int PH>
__global__ void __launch_bounds__(NTHREADS) phase_kernel(Params P) {
    if (PH == 0) phase0(P, dyn_smem);
    if (PH == 1) phase1(P, dyn_smem);
    if (PH == 2) phase2(P, dyn_smem);
    if (PH == 3) phase3(P, dyn_smem);
    if (PH == 4) phase4(P, dyn_smem);
    if (PH == 5) phase5(P, dyn_smem);
    if (PH == 6) phase6(P, dyn_smem);
    if (PH == 7) phase7(P, dyn_smem);
    if (PH == 8) phase8(P, dyn_smem);
}

template <int PH>
static void launch_phase(const Params& p, hipStream_t stream) {
    static bool attr = false;
    if (!attr) { (void)hipFuncSetAttribute((const void*)phase_kernel<PH>, hipFuncAttributeMaxDynamicSharedMemorySize, SMEM_BYTES); attr = true; }
    phase_kernel<PH><<<256, NTHREADS, SMEM_BYTES, stream>>>(p);
}

extern "C" void kernel_launch(void* const* d_in, const int* in_sizes, int n_in, void* d_out, int out_size, void* d_ws, size_t ws_size,
                              hipStream_t stream) {
    Params p{};
    const float* const* in = (const float* const*)d_in;
    p.x_prompt = in[0]; p.x_sample = in[1]; p.cache_k = in[2]; p.cache_v = in[3]; p.cache_idx_k = in[4];
    p.st_re = in[5]; p.st_im = in[6]; p.c_prompt = in[7]; p.c_sample = in[8];
    p.w_mod = in[9]; p.b_mod = in[10]; p.g_norm = in[11]; p.w_in = in[12];
    p.lam_re = in[13]; p.lam_im = in[14]; p.log_dt = in[15]; p.b_re = in[16]; p.b_im = in[17];
    p.c_re = in[18]; p.c_im = in[19]; p.d_skip = in[20]; p.w_glu = in[21]; p.w_ap = in[22]; p.w_sp = in[23];
    p.w_out = in[24]; p.g_final = in[25];
    p.out = (float*)d_out;
    p.ws = (char*)d_ws;
    if (ws_size < W_END) { fprintf(stderr, "workspace too small: %zu < %zu\n", ws_size, (size_t)W_END); return; }
#if MEGA
    static int grid_blocks = 0;
    if (!grid_blocks) {
        (void)hipFuncSetAttribute((const void*)mega_kernel, hipFuncAttributeMaxDynamicSharedMemorySize, SMEM_BYTES);
        int dev = 0, cus = 0, per_cu = 0;
        (void)hipGetDevice(&dev);
        (void)hipDeviceGetAttribute(&cus, hipDeviceAttributeMultiprocessorCount, dev);
        (void)hipOccupancyMaxActiveBlocksPerMultiprocessor(&per_cu, mega_kernel, NTHREADS, SMEM_BYTES);
        if (per_cu > 1) per_cu = 1;
        grid_blocks = cus * per_cu;
    }
    (void)hipMemsetAsync(p.ws + W_CNT, 0, W_WTIN - W_CNT, stream);
    void* args[] = {&p};
    hipError_t e = hipLaunchCooperativeKernel((void*)mega_kernel, dim3(grid_blocks), dim3(NTHREADS), args, SMEM_BYTES, stream);
    if (e != hipSuccess) fprintf(stderr, "cooperative launch failed: %s (grid %d)\n", hipGetErrorString(e), grid_blocks);
#else
    (void)hipMemsetAsync(p.ws + W_CNT, 0, W_WTIN - W_CNT, stream);
#ifndef PROBE_SET
#define PROBE_SET 0
#endif
    launch_phase<0>(p, stream); if (PROBE_SET & 1) launch_phase<0>(p, stream);
    launch_phase<1>(p, stream); if (PROBE_SET & 2) launch_phase<1>(p, stream);
    launch_phase<2>(p, stream); if (PROBE_SET & 4) launch_phase<2>(p, stream);
    launch_phase<3>(p, stream); if (PROBE_SET & 8) launch_phase<3>(p, stream);
    launch_phase<4>(p, stream);
    launch_phase<5>(p, stream); if (PROBE_SET & 32) launch_phase<5>(p, stream);
    launch_phase<6>(p, stream); if (PROBE_SET & 64) launch_phase<6>(p, stream);
    launch_phase<7>(p, stream); if (PROBE_SET & 128) launch_phase<7>(p, stream);
    launch_phase<8>(p, stream);
#endif
}
```

```cpp
#include <hip/hip_runtime.h>
#include <hip/hip_cooperative_groups.h>
#include <cstdio>
namespace cg = cooperative_groups;

#ifndef MEGA
#define MEGA 1
#endif

typedef unsigned short bf16_t;
typedef short bf16x8 __attribute__((ext_vector_type(8)));
typedef float f32x16 __attribute__((ext_vector_type(16)));
typedef float f32x4 __attribute__((ext_vector_type(4)));
typedef float f32x2 __attribute__((ext_vector_type(2)));

constexpr int D = 1024, NP = 32768, NS = 2048, NTOK = NP + NS;
constexpr int NIN = 4936, NINP = 4992, NINP2 = 5120;
constexpr int SCLD = 2056;
constexpr int SMEM_BYTES = 143360;
constexpr int NTHREADS = 512;

constexpr size_t O_Y = 0;
constexpr size_t O_KP = (size_t)NTOK * 1024;
constexpr size_t O_VP = O_KP + (size_t)NP * 128;
constexpr size_t O_KIP = O_VP + (size_t)NP * 128;
constexpr size_t O_HRP = O_KIP + (size_t)NP * 64;
constexpr size_t O_HIP = O_HRP + 16 * 32 * 64;
constexpr size_t O_KS = O_HIP + 16 * 32 * 64;
constexpr size_t O_VS = O_KS + (size_t)NS * 128;
constexpr size_t O_KIS = O_VS + (size_t)NS * 128;
constexpr size_t O_HRS = O_KIS + (size_t)NS * 64;
constexpr size_t O_HIS = O_HRS + 32 * 32 * 64;

constexpr size_t al(size_t x) { return (x + 255) & ~(size_t)255; }
constexpr size_t W_CNT = 0;
constexpr size_t W_BAR = 256;
constexpr size_t W_WTIN = W_BAR + 3456 * 4;
constexpr size_t W_WTGLU = W_WTIN + al((size_t)NINP2 * 1024 * 2);
constexpr size_t W_WTAP = W_WTGLU + al((size_t)1024 * 512 * 2);
constexpr size_t W_WTSP = W_WTAP + al((size_t)1024 * 512 * 2);
constexpr size_t W_WTOUT = W_WTSP + al((size_t)1024 * 512 * 2);
constexpr size_t W_MODP = W_WTOUT + al((size_t)1024 * 1024 * 2);
constexpr size_t W_MODF = W_MODP + al((size_t)8 * 48 * 3072 * 4);
constexpr size_t W_ROPE = W_MODF + al((size_t)48 * 3072 * 4);
constexpr size_t W_BT = W_ROPE + al((size_t)2048 * 16 * 4);
constexpr size_t W_WE = W_BT + al((size_t)32 * 128 * 16 * 2);
constexpr size_t W_A1 = W_WE + al((size_t)32 * 128 * 512 * 2);
constexpr size_t W_A32 = W_A1 + al((size_t)32 * 64 * 2 * 4);
constexpr size_t W_CC = W_A32 + al((size_t)32 * 64 * 2 * 4);
constexpr size_t W_H = W_CC + al((size_t)32 * 16 * 128 * 2);
constexpr size_t W_Q = W_H + al((size_t)NTOK * 1024 * 2);
constexpr size_t W_QI = W_Q + al((size_t)NTOK * 512 * 2);
constexpr size_t W_WI = W_QI + al((size_t)NTOK * 512 * 2);
constexpr size_t W_KP = W_WI + al((size_t)NTOK * 8 * 4);
constexpr size_t W_VTP = W_KP + al((size_t)NP * 128 * 2);
constexpr size_t W_KIP = W_VTP + al((size_t)NP * 128 * 2);
constexpr size_t W_KS = W_KIP + al((size_t)NP * 64 * 2);
constexpr size_t W_VTS = W_KS + al((size_t)32 * 1088 * 128 * 2);
constexpr size_t W_KIS = W_VTS + al((size_t)32 * 1088 * 128 * 2);
constexpr size_t W_GA = W_KIS + al((size_t)32 * 1088 * 64 * 2);
constexpr size_t W_U = W_GA + al((size_t)NTOK * 512 * 2);
constexpr size_t W_GS = W_U + al((size_t)NTOK * 512 * 2);
constexpr size_t W_MA = W_GS + al((size_t)NTOK * 512 * 2);
constexpr size_t W_MB = W_MA + al((size_t)NTOK * 1024 * 2);
constexpr size_t W_E = W_MB + al((size_t)NTOK * 1024 * 2);
constexpr size_t W_END = W_E + al((size_t)1088 * 32 * 128 * 4);

struct Params {
    const float *x_prompt, *x_sample, *cache_k, *cache_v, *cache_idx_k, *st_re, *st_im, *c_prompt, *c_sample;
    const float *w_mod, *b_mod, *g_norm, *w_in, *lam_re, *lam_im, *log_dt, *b_re, *b_im, *c_re, *c_im, *d_skip;
    const float *w_glu, *w_ap, *w_sp, *w_out, *g_final;
    float* out;
    char* ws;
};

__device__ __forceinline__ unsigned pack2(float lo, float hi) {
    unsigned r;
    asm("v_cvt_pk_bf16_f32 %0, %1, %2" : "=v"(r) : "v"(lo), "v"(hi));
    return r;
}
__device__ __forceinline__ bf16_t f2bf(float f) { return (bf16_t)(pack2(f, 0.f) & 0xffffu); }
__device__ __forceinline__ float bf2f(bf16_t b) { return __uint_as_float(((unsigned)b) << 16); }
__device__ __forceinline__ float bflo(unsigned u) { return __uint_as_float(u << 16); }
__device__ __forceinline__ float bfhi(unsigned u) { return __uint_as_float(u & 0xffff0000u); }
__device__ __forceinline__ float fexp2(float x) { return __builtin_amdgcn_exp2f(x); }
__device__ __forceinline__ float frcp(float x) { return __builtin_amdgcn_rcpf(x); }
__device__ __forceinline__ float sigmoidf_(float x) { return frcp(1.f + fexp2(-1.44269504f * x)); }
__device__ __forceinline__ float siluf_(float x) { return x * sigmoidf_(x); }
__device__ __forceinline__ float geluf_(float x) {
    const float inner = x * (1.f + 0.044715f * x * x);
    return x * frcp(1.f + fexp2(-2.f * 0.7978845608f * 1.44269504f * inner));
}
__device__ __forceinline__ void sincos_big(float ang, float& s, float& c) {
    const float C_HI = 0.15915494309189535f;
    const float C_LO = 6.4206382e-09f;
    float p = ang * C_HI;
    float e = fmaf(ang, C_HI, -p) + ang * C_LO;
    float fr = p - rintf(p);
    fr += e;
    s = __builtin_amdgcn_sinf(fr);
    c = __builtin_amdgcn_cosf(fr);
}
__device__ __forceinline__ const float* xrow(const Params& P, int tok) {
    return tok < NP ? P.x_prompt + (size_t)tok * D : P.x_sample + (size_t)(tok - NP) * D;
}
__device__ __forceinline__ int modrow(int tok) { return tok < NP ? (tok >> 11) : 16 + ((tok - NP) >> 6); }
__device__ __forceinline__ void st_bf4(bf16_t* p, float a, float b, float c, float d) {
    uint2 v; v.x = pack2(a, b); v.y = pack2(c, d);
    *(uint2*)p = v;
}
__device__ __forceinline__ size_t kf_index(int bg, int nt, int key, int d0) {
    return ((((size_t)bg * nt + (key >> 5)) * 4 + ((d0 >> 3) & 3)) * 64 + (d0 >> 5) * 32 + (key & 31)) * 8 + (d0 & 7);
}
__device__ __forceinline__ size_t vf_index(int bg, int nt, int key, int d) {
    const int kk = key & 31, s2 = kk >> 4, r = kk & 15, hh = (r >> 2) & 1, j = (r >> 3) * 4 + (r & 3);
    return (((((size_t)bg * nt + (key >> 5)) * 2 + s2) * 2 + (d >> 5)) * 64 + hh * 32 + (d & 31)) * 8 + j;
}
#define MFMA32(a, b, c) __builtin_amdgcn_mfma_f32_32x32x16_bf16((a), (b), (c), 0, 0, 0)
#define MFMA16(a, b, c) __builtin_amdgcn_mfma_f32_16x16x32_bf16((a), (b), (c), 0, 0, 0)

template <int MODE>
__device__ __forceinline__ int colmap(int n) {
    if (MODE == 0) {
        if (n < 1352) return n;
        if (n < 1408 || n >= NINP) return -1;
        return n - 56;
    } else if (MODE == 1) {
        return (n >> 3) * 4 + ((n & 4) ? 512 : 0);
    } else return n;
}
template <int MODE>
__device__ __forceinline__ void transpose_tiles4(const float* __restrict__ src, int ldsrc, int K, bf16_t* __restrict__ dst, int t0, int ntn, char* smem) {
    const int tid = threadIdx.x;
    float4 v[4][2];
#pragma unroll
    for (int q = 0; q < 4; ++q) {
        const int kt = (t0 + q) / ntn, nt = (t0 + q) % ntn;
#pragma unroll
        for (int i = 0; i < 2; ++i) {
            const int k = (tid >> 4) + 32 * i, n4 = (tid & 15) * 4;
            const int sc = colmap<MODE>(nt * 64 + n4);
            v[q][i] = make_float4(0.f, 0.f, 0.f, 0.f);
            if (sc >= 0) v[q][i] = *(const float4*)(src + (size_t)(kt * 64 + k) * ldsrc + sc);
        }
    }
#pragma unroll
    for (int q = 0; q < 4; ++q) {
        bf16_t* tile = (bf16_t*)smem + q * (64 * 72);
#pragma unroll
        for (int i = 0; i < 2; ++i) {
            const int k = (tid >> 4) + 32 * i, n4 = (tid & 15) * 4;
            tile[(n4 + 0) * 72 + k] = f2bf(v[q][i].x);
            tile[(n4 + 1) * 72 + k] = f2bf(v[q][i].y);
            tile[(n4 + 2) * 72 + k] = f2bf(v[q][i].z);
            tile[(n4 + 3) * 72 + k] = f2bf(v[q][i].w);
        }
    }
    __syncthreads();
#pragma unroll
    for (int q = 0; q < 4; ++q) {
        const int kt = (t0 + q) / ntn, nt = (t0 + q) % ntn;
        const bf16_t* tile = (const bf16_t*)smem + q * (64 * 72);
        const int n = tid >> 3, ch = tid & 7;
        const uint4 w = *(const uint4*)(tile + n * 72 + ch * 8);
        *(uint4*)(dst + (size_t)(nt * 64 + n) * K + kt * 64 + ch * 8) = w;
    }
    __syncthreads();
}

__device__ __forceinline__ void phase0(const Params& P, char* smem) {
    const int bid = blockIdx.x, nb = gridDim.x, tid = threadIdx.x, lane = tid & 63, wave = tid >> 6;
    char* ws = P.ws;
    {
        float* csil = (float*)smem;
        float* red = (float*)(smem + 24576);
        float* modp = (float*)(ws + W_MODP);
        for (int task = bid; task < 384; task += nb) {
            const int jb = task % 48, ks = task / 48, k0 = ks * 128;
            for (int idx = tid; idx < 6144; idx += NTHREADS) {
                const int k = idx / 48, r = idx % 48;
                const float cv = r < 16 ? P.c_prompt[r * 1024 + k0 + k] : P.c_sample[(r - 16) * 1024 + k0 + k];
                csil[k * 48 + r] = siluf_(cv);
            }
            __syncthreads();
            float acc[48];
#pragma unroll
            for (int r = 0; r < 48; ++r) acc[r] = 0.f;
            float wpre[16];
#pragma unroll
            for (int kk = 0; kk < 16; ++kk) wpre[kk] = P.w_mod[(size_t)(k0 + 16 * wave + kk) * 3072 + jb * 64 + lane];
#pragma unroll
            for (int kk = 0; kk < 16; ++kk) {
                const int k = 16 * wave + kk;
                const float wv = wpre[kk];
#pragma unroll
                for (int r4 = 0; r4 < 12; ++r4) {
                    const float4 c4 = *(const float4*)(csil + k * 48 + 4 * r4);
                    acc[4 * r4 + 0] += wv * c4.x; acc[4 * r4 + 1] += wv * c4.y;
                    acc[4 * r4 + 2] += wv * c4.z; acc[4 * r4 + 3] += wv * c4.w;
                }
            }
#pragma unroll
            for (int r = 0; r < 48; ++r) red[(wave * 48 + r) * 64 + lane] = acc[r];
            __syncthreads();
            for (int idx = tid; idx < 3072; idx += NTHREADS) {
                const int r = idx >> 6, col = idx & 63;
                float s = 0.f;
#pragma unroll
                for (int w = 0; w < 8; ++w) s += red[(w * 48 + r) * 64 + col];
                modp[(size_t)(ks * 48 + r) * 3072 + jb * 64 + col] = s;
            }
            __syncthreads();
        }
    }
    {
        const int T_IN = 16 * 80 / 4, T_G = 8 * 16 / 4, T_O = 16 * 16 / 4;
        const int total = T_IN + 3 * T_G + T_O;
        for (int task = bid; task < total; task += nb) {
            int t = task;
            if (t < T_IN) { transpose_tiles4<0>(P.w_in, NIN, 1024, (bf16_t*)(ws + W_WTIN), t * 4, 80, smem); continue; }
            t -= T_IN;
            if (t < T_G) { transpose_tiles4<1>(P.w_glu, 1024, 512, (bf16_t*)(ws + W_WTGLU), t * 4, 16, smem); continue; }
            t -= T_G;
            if (t < T_G) { transpose_tiles4<2>(P.w_ap, 1024, 512, (bf16_t*)(ws + W_WTAP), t * 4, 16, smem); continue; }
            t -= T_G;
            if (t < T_G) { transpose_tiles4<2>(P.w_sp, 1024, 512, (bf16_t*)(ws + W_WTSP), t * 4, 16, smem); continue; }
            t -= T_G;
            transpose_tiles4<2>(P.w_out, 1024, 1024, (bf16_t*)(ws + W_WTOUT), t * 4, 16, smem);
        }
    }
    const int gtid = bid * NTHREADS + tid, gn = nb * NTHREADS;
    {
        float* rt = (float*)(ws + W_ROPE);
        for (int idx = gtid; idx < 2048 * 8; idx += gn) {
            const int pos = idx >> 3, f = idx & 7;
            const float inv = fexp2(-(float)f * 0.125f * 18.931568569324174f);
            float s, c;
            sincos_big((float)pos * inv, s, c);
            rt[pos * 16 + f] = c; rt[pos * 16 + 8 + f] = s;
        }
    }
    {
        bf16_t* Bt = (bf16_t*)(ws + W_BT);
        bf16_t* WE = (bf16_t*)(ws + W_WE);
        float* A1 = (float*)(ws + W_A1);
        float* A32 = (float*)(ws + W_A32);
        for (int idx = gtid; idx < 32 * 64 * 32; idx += gn) {
            const int s = idx & 31, gp = idx >> 5, g = gp >> 6, p = gp & 63;
            const float dt = __expf(P.log_dt[g]);
            const float lr = P.lam_re[gp], li = P.lam_im[gp];
            float sn, cs;
            sincos_big(li * dt, sn, cs);
            const float mag = __expf(lr * dt);
            const float ar = mag * cs, ai = mag * sn;
            const float den = lr * lr + li * li;
            const float zr = ((ar - 1.f) * lr + ai * li) / den;
            const float zi = (ai * lr - (ar - 1.f) * li) / den;
            if (s == 0) {
                A1[gp * 2] = ar; A1[gp * 2 + 1] = ai;
                float s32, c32;
                sincos_big(li * dt * 32.f, s32, c32);
                const float m32 = __expf(lr * dt * 32.f);
                A32[gp * 2] = m32 * c32; A32[gp * 2 + 1] = m32 * s32;
            }
            const float m = (float)(31 - s);
            float sp, cp;
            sincos_big(li * dt * m, sp, cp);
            const float mp = __expf(lr * dt * m);
            const float pr = mp * cp, pi = mp * sp;
#pragma unroll
            for (int c = 0; c < 16; ++c) {
                const float br = P.b_re[(size_t)gp * 16 + c], bi = P.b_im[(size_t)gp * 16 + c];
                const float bbr = zr * br - zi * bi, bbi = zr * bi + zi * br;
                if (s == 0) {
                    Bt[((size_t)g * 128 + p) * 16 + c] = f2bf(bbr);
                    Bt[((size_t)g * 128 + 64 + p) * 16 + c] = f2bf(bbi);
                }
                WE[((size_t)g * 128 + p) * 512 + s * 16 + c] = f2bf(pr * bbr - pi * bbi);
                WE[((size_t)g * 128 + 64 + p) * 512 + s * 16 + c] = f2bf(pr * bbi + pi * bbr);
            }
        }
        bf16_t* Cc = (bf16_t*)(ws + W_CC);
        for (int idx = gtid; idx < 32 * 16 * 128; idx += gn) {
            const int pos = idx & 127, gc = idx >> 7;
            const int pl = pos >> 2, ct = pos & 3;
            const int p = pl + 32 * (ct & 1);
            const float v = (ct >> 1) ? -P.c_im[(size_t)gc * 64 + p] : P.c_re[(size_t)gc * 64 + p];
            Cc[idx] = f2bf(v);
        }
    }
    {
        bf16_t* Ks = (bf16_t*)(ws + W_KS);
        bf16_t* KIs = (bf16_t*)(ws + W_KIS);
        bf16_t* Vts = (bf16_t*)(ws + W_VTS);
        for (int base = gtid; base < 32 * 1024 * 32; base += 8 * gn) {
            float4 v[8];
#pragma unroll
            for (int u = 0; u < 8; ++u) { const int idx = base + u * gn; if (idx < 32 * 1024 * 32) v[u] = *(const float4*)(P.cache_k + (size_t)idx * 4); }
#pragma unroll
            for (int u = 0; u < 8; ++u) {
                const int idx = base + u * gn;
                if (idx < 32 * 1024 * 32) {
                    const int c4 = idx & 31, bl = idx >> 5, b = bl >> 10, l = bl & 1023, c = c4 * 4;
                    st_bf4(Ks + kf_index(b * 2 + (c >> 6), 34, l, c & 63), v[u].x, v[u].y, v[u].z, v[u].w);
                }
            }
        }
        for (int base = gtid; base < 32 * 1024 * 16; base += 4 * gn) {
            float4 v[4];
#pragma unroll
            for (int u = 0; u < 4; ++u) { const int idx = base + u * gn; if (idx < 32 * 1024 * 16) v[u] = *(const float4*)(P.cache_idx_k + (size_t)idx * 4); }
#pragma unroll
            for (int u = 0; u < 4; ++u) {
                const int idx = base + u * gn;
                if (idx < 32 * 1024 * 16) {
                    const int c4 = idx & 15, bl = idx >> 4, b = bl >> 10, l = bl & 1023;
                    st_bf4(KIs + kf_index(b, 34, l, c4 * 4), v[u].x, v[u].y, v[u].z, v[u].w);
                }
            }
        }
        for (int base = gtid; base < 32 * 256 * 128; base += 4 * gn) {
            float v[4][4];
#pragma unroll
            for (int u = 0; u < 4; ++u) {
                const int idx = base + u * gn;
                if (idx < 32 * 256 * 128) {
                    const int gd = idx & 127, rest = idx >> 7, l4 = rest & 255, b = rest >> 8;
                    const float* src = P.cache_v + ((size_t)b * 1024 + l4 * 4) * 128 + gd;
                    v[u][0] = src[0]; v[u][1] = src[128]; v[u][2] = src[256]; v[u][3] = src[384];
                }
            }
#pragma unroll
            for (int u = 0; u < 4; ++u) {
                const int idx = base + u * gn;
                if (idx < 32 * 256 * 128) {
                    const int gd = idx & 127, rest = idx >> 7, l4 = rest & 255, b = rest >> 8;
                    st_bf4(Vts + vf_index(b * 2 + (gd >> 6), 34, l4 * 4, gd & 63), v[u][0], v[u][1], v[u][2], v[u][3]);
                }
            }
        }
    }
}

__device__ __forceinline__ void phase1(const Params& P, char* smem) {
    const int bid = blockIdx.x, nb = gridDim.x, tid = threadIdx.x, lane = tid & 63, wave = tid >> 6;
    char* ws = P.ws;
    const float* modp = (const float*)(ws + W_MODP);
    {
        float* modf = (float*)(ws + W_MODF);
        for (int idx = bid * NTHREADS + tid; idx < 48 * 3072; idx += nb * NTHREADS) {
            float s = P.b_mod[idx % 3072];
#pragma unroll
            for (int k = 0; k < 8; ++k) s += modp[(size_t)k * 48 * 3072 + idx];
            modf[idx] = s;
        }
    }
    float* gsc = (float*)smem;
    float* shf = gsc + 1024;
    bf16_t* H = (bf16_t*)(ws + W_H);
    for (int task = bid; task < NTOK / 64; task += nb) {
        const int tok0 = task * 64, r = modrow(tok0);
        for (int k = tid; k < 1024; k += NTHREADS) {
            float sh = P.b_mod[k], sc = P.b_mod[1024 + k];
#pragma unroll
            for (int s = 0; s < 8; ++s) {
                sh += modp[(size_t)(s * 48 + r) * 3072 + k];
                sc += modp[(size_t)(s * 48 + r) * 3072 + 1024 + k];
            }
            gsc[k] = P.g_norm[k] * (1.f + sc);
            shf[k] = sh;
        }
        __syncthreads();
        for (int rb = 0; rb < 2; ++rb) {
            float4 v[4][4];
#pragma unroll
            for (int r4 = 0; r4 < 4; ++r4) {
                const float* x = xrow(P, tok0 + wave * 8 + rb * 4 + r4);
#pragma unroll
                for (int i = 0; i < 4; ++i) v[r4][i] = *(const float4*)(x + 4 * lane + 256 * i);
            }
#pragma unroll
            for (int r4 = 0; r4 < 4; ++r4) {
                const int tok = tok0 + wave * 8 + rb * 4 + r4;
                float ss = 0.f;
#pragma unroll
                for (int i = 0; i < 4; ++i) ss += v[r4][i].x * v[r4][i].x + v[r4][i].y * v[r4][i].y + v[r4][i].z * v[r4][i].z + v[r4][i].w * v[r4][i].w;
#pragma unroll
                for (int o = 32; o >= 1; o >>= 1) ss += __shfl_xor(ss, o);
                const float rinv = rsqrtf(ss * (1.f / 1024.f) + 1e-6f);
#pragma unroll
                for (int i = 0; i < 4; ++i) {
                    const int k = 4 * lane + 256 * i;
                    const float4 g4 = *(const float4*)(gsc + k), s4 = *(const float4*)(shf + k);
                    st_bf4(H + (size_t)tok * 1024 + k, v[r4][i].x * rinv * g4.x + s4.x, v[r4][i].y * rinv * g4.y + s4.y,
                           v[r4][i].z * rinv * g4.z + s4.z, v[r4][i].w * rinv * g4.w + s4.w);
                }
            }
        }
        __syncthreads();
    }
}

namespace pg8 {
#define PG8_LAS __attribute__((address_space(3)))
constexpr int BM = 256, BK = 64, HALF = 128, HTB = HALF * BK * 2, STAGE_BYTES = 8 * HTB, NXCD = 8, WGM = 8;
__device__ __forceinline__ int lds_byte(int r, int c) { const int st = (r >> 4) * 2 + (c >> 5), rr = r & 15, cc = c & 31, ob = rr * 64 + cc * 2; return st * 1024 + (ob ^ (((ob >> 9) & 1) << 5)); }
__device__ __forceinline__ void stage_rc(int b, int& R, int& C) { const int st = b / 1024, sb = b % 1024, swz = sb ^ (((sb >> 9) & 1) << 5); R = (st >> 1) * 16 + swz / 64; C = (st & 1) * 32 + (swz % 64) / 2; }
__device__ __forceinline__ int perm32(int rho) { const int n = rho >> 4, i = rho & 15; return 8 * (i >> 2) + 4 * n + (i & 3); }
struct Unit { int pm, pn; };
struct Gemm { const bf16_t* A; const bf16_t* Bt; int M, N, K; };
struct StaticOrder {
    int nM, nN, nwg, G, c;
    __device__ void init(int M, int N, int G_, int c_) { nM = M / BM; nN = N / BM; nwg = nM * nN; G = G_; c = c_; }
    __device__ bool next(int i, Unit& u) const {
        const long L = (long)i * G + c; if (L >= nwg) return false;
        int wgid = (int)L; { const int q = nwg / NXCD, r = nwg % NXCD, xcd = wgid % NXCD, off = wgid / NXCD; wgid = (xcd < r ? xcd * (q + 1) : r * (q + 1) + (xcd - r) * q) + off; }
        const int nig = WGM * nN, gid = wgid / nig, fm = gid * WGM, gsz = (nM - fm) < WGM ? (nM - fm) : WGM;
        u.pm = fm + ((wgid % nig) % gsz); u.pn = (wgid % nig) / gsz; return true;
    }
};
template <class Epi>
__device__ __forceinline__ void gemm_phase(PG8_LAS unsigned char* lds, const Gemm g, const StaticOrder& S, const Epi& E) {
    int tid = threadIdx.x;
    asm volatile("" : "+v"(tid));
    const int wid = __builtin_amdgcn_readfirstlane(tid >> 6), lane = tid & 63, wr = wid >> 2, wc = wid & 3, fr = lane & 15, fq = lane >> 4;
    const int K = g.K, nt = K / BK;
    unsigned voffA[2], voffB[2];
#pragma unroll
    for (int i = 0; i < 2; ++i) { int R, C; stage_rc(tid * 16 + i * 8192, R, C); const int Rb = (R & ~31) + perm32(R & 31);
        voffA[i] = (unsigned)(R * K + C) * 2u; voffB[i] = (unsigned)(Rb * K + C) * 2u; }
    const size_t kstep = (size_t)(BK * 2);
    const size_t hstep = (size_t)HALF * K * 2;
    const size_t tstep = 2 * hstep;
    const unsigned ldsw = (unsigned)wid * 1024u;
    const int aoff = lds_byte(wr * 64 + fr, fq * 8), boff = lds_byte(wc * 32 + fr, fq * 8);
#define PG8_SA(b, h) (((b) * 2 + (h)) * HTB)
#define PG8_SB(b, h) ((4 + (b) * 2 + (h)) * HTB)
#define PG8_STAGE(bufoff, gbase, voff) do { _Pragma("unroll") for (int _i = 0; _i < 2; ++_i) \
        __builtin_amdgcn_global_load_lds((const unsigned*)((const char*)(gbase) + (voff)[_i]), (PG8_LAS unsigned*)(lds + (bufoff) + ldsw + _i * 8192), 16, 0, 0); } while (0)
#define PG8_LDA(dst, b, h) do { _Pragma("unroll") for (int m = 0; m < 4; ++m) _Pragma("unroll") for (int k = 0; k < 2; ++k) dst[m][k] = *(const PG8_LAS bf16x8*)(lds + PG8_SA(b, h) + aoff + m * 2048 + k * 1024); } while (0)
#define PG8_LDB(dst, b, h) do { _Pragma("unroll") for (int n = 0; n < 2; ++n) _Pragma("unroll") for (int k = 0; k < 2; ++k) dst[n][k] = *(const PG8_LAS bf16x8*)(lds + PG8_SB(b, h) + boff + n * 2048 + k * 1024); } while (0)
#define PG8_MMA(ai, bj, At, Bt) do { __builtin_amdgcn_s_setprio(1); _Pragma("unroll") for (int m = 0; m < 4; ++m) _Pragma("unroll") for (int n = 0; n < 2; ++n) _Pragma("unroll") for (int k = 0; k < 2; ++k) \
        acc[ai][bj][m][n] = __builtin_amdgcn_mfma_f32_16x16x32_bf16(Bt[n][k], At[m][k], acc[ai][bj][m][n], 0, 0, 0); __builtin_amdgcn_s_setprio(0); } while (0)
#define PG8_WAIT_V(n) asm volatile("s_waitcnt vmcnt(" #n ")" ::: "memory")
#define PG8_WAIT_L(n) asm volatile("s_waitcnt lgkmcnt(" #n ")" ::: "memory")
#define PG8_BAR __builtin_amdgcn_s_barrier()
#define PG8_SCHED __builtin_amdgcn_sched_barrier(0)
    Unit cur, nxt; int ui = 0;
    if (!S.next(0, cur)) return;
    f32x4 acc[2][2][4][2];
#pragma unroll
    for (int a = 0; a < 2; ++a)
#pragma unroll
        for (int b = 0; b < 2; ++b)
#pragma unroll
            for (int m = 0; m < 4; ++m)
#pragma unroll
                for (int n = 0; n < 2; ++n) acc[a][b][m][n] = (f32x4){0.f, 0.f, 0.f, 0.f};
    bf16x8 At[4][2], B0[2][2], B1[2][2];
    const char* cA = (const char*)g.A + (size_t)cur.pm * tstep; const char* cB = (const char*)g.Bt + (size_t)cur.pn * tstep;
    PG8_STAGE(PG8_SB(0, 0), cB, voffB); PG8_STAGE(PG8_SA(0, 0), cA, voffA); PG8_STAGE(PG8_SB(0, 1), cB + hstep, voffB); PG8_STAGE(PG8_SA(0, 1), cA + hstep, voffA);
    if (wr == 1) PG8_BAR;
    PG8_WAIT_V(4); PG8_BAR;
    PG8_STAGE(PG8_SB(1, 0), cB + kstep, voffB); PG8_STAGE(PG8_SA(1, 0), cA + kstep, voffA); PG8_STAGE(PG8_SB(1, 1), cB + hstep + kstep, voffB);
    PG8_WAIT_V(6); PG8_BAR;
    for (;;) {
        const bool has_next = S.next(ui + 1, nxt);
        const char* nA = has_next ? (const char*)g.A + (size_t)nxt.pm * tstep : cA; const char* nB = has_next ? (const char*)g.Bt + (size_t)nxt.pn * tstep : cB;
        for (int t = 0; t < nt; t += 2) {
            const bool last = (t == nt - 2);
            const char* a1 = cA + (size_t)(t + 1) * kstep;
            const char* a2 = last ? nA : cA + (size_t)(t + 2) * kstep; const char* b2 = last ? nB : cB + (size_t)(t + 2) * kstep;
            const char* a3 = a2 + kstep; const char* b3 = b2 + kstep;
            PG8_LDB(B0, 0, 0); PG8_SCHED; PG8_LDA(At, 0, 0); PG8_STAGE(PG8_SA(1, 1), a1 + hstep, voffA);
            PG8_WAIT_L(8); PG8_BAR; PG8_WAIT_L(0); PG8_MMA(0, 0, At, B0); PG8_BAR; PG8_SCHED;
            PG8_LDB(B1, 0, 1); PG8_STAGE(PG8_SB(0, 0), b2, voffB);
            PG8_BAR; PG8_WAIT_L(0); PG8_MMA(0, 1, At, B1); PG8_BAR;
            PG8_LDA(At, 0, 1); PG8_STAGE(PG8_SA(0, 0), a2, voffA);
            PG8_BAR; PG8_WAIT_L(0); PG8_MMA(1, 0, At, B0); PG8_BAR; PG8_SCHED;
            PG8_STAGE(PG8_SB(0, 1), b2 + hstep, voffB);
            PG8_WAIT_V(6); PG8_BAR; PG8_MMA(1, 1, At, B1); PG8_BAR;
            PG8_LDB(B0, 1, 0); PG8_SCHED; PG8_LDA(At, 1, 0); PG8_STAGE(PG8_SA(0, 1), a2 + hstep, voffA);
            PG8_WAIT_L(8); PG8_BAR; PG8_WAIT_L(0); PG8_MMA(0, 0, At, B0); PG8_BAR; PG8_SCHED;
            PG8_LDB(B1, 1, 1); PG8_STAGE(PG8_SB(1, 0), b3, voffB);
            PG8_BAR; PG8_WAIT_L(0); PG8_MMA(0, 1, At, B1); PG8_BAR;
            PG8_LDA(At, 1, 1); PG8_STAGE(PG8_SA(1, 0), a3, voffA);
            PG8_BAR; PG8_WAIT_L(0); PG8_MMA(1, 0, At, B0); PG8_BAR; PG8_SCHED;
            PG8_STAGE(PG8_SB(1, 1), b3 + hstep, voffB);
            PG8_WAIT_V(6); PG8_BAR; PG8_MMA(1, 1, At, B1); PG8_BAR;
        }
        E(acc, cur, wr, wc, fr, fq);
        if (!has_next) break;
#pragma unroll
        for (int a = 0; a < 2; ++a)
#pragma unroll
            for (int b = 0; b < 2; ++b)
#pragma unroll
                for (int m = 0; m < 4; ++m)
#pragma unroll
                    for (int n = 0; n < 2; ++n) acc[a][b][m][n] = (f32x4){0.f, 0.f, 0.f, 0.f};
        cur = nxt; cA = nA; cB = nB; ++ui;
    }
    PG8_WAIT_V(0);
    if (wr == 0) PG8_BAR;
    PG8_BAR;
#undef PG8_SA
#undef PG8_SB
#undef PG8_STAGE
#undef PG8_LDA
#undef PG8_LDB
#undef PG8_MMA
#undef PG8_WAIT_V
#undef PG8_WAIT_L
#undef PG8_BAR
#undef PG8_SCHED
}
}

__device__ __forceinline__ void st_bf8(bf16_t* p, const f32x4& a, const f32x4& b) {
    uint4 v; v.x = pack2(a[0], a[1]); v.y = pack2(a[2], a[3]); v.z = pack2(b[0], b[1]); v.w = pack2(b[2], b[3]);
    *(uint4*)p = v;
}
template <int ACT> __device__ __forceinline__ f32x4 act4(f32x4 v) {
    if (ACT == 1) { v[0] = siluf_(v[0]); v[1] = siluf_(v[1]); v[2] = siluf_(v[2]); v[3] = siluf_(v[3]); }
    if (ACT == 2) { v[0] = sigmoidf_(v[0]); v[1] = sigmoidf_(v[1]); v[2] = sigmoidf_(v[2]); v[3] = sigmoidf_(v[3]); }
    return v;
}

struct EpiIn {
    Params P;
    __device__ __forceinline__ void operator()(const f32x4 (&acc)[2][2][4][2], const pg8::Unit& u, int wr, int wc, int fr, int fq) const {
        char* ws = P.ws;
        const float* rt = (const float*)(ws + W_ROPE);
#pragma unroll
        for (int bj = 0; bj < 2; ++bj) {
            const int c32 = u.pn * 256 + bj * 128 + wc * 32;
            if (c32 >= NINP || c32 == 1376) continue;
            const int cl = 8 * fq;
#pragma unroll
            for (int ai = 0; ai < 2; ++ai)
#pragma unroll
                for (int m = 0; m < 4; ++m) {
                    const int tok = u.pm * 256 + ai * 128 + wr * 64 + m * 16 + fr;
                    const bool smp = tok >= NP;
                    const int st = tok - NP;
                    const int b = smp ? (st >> 6) : (tok >> 11);
                    const int t = smp ? (st & 63) : (tok & 2047);
                    const int pos = smp ? 1024 + t : t;
                    f32x4 v0 = acc[ai][bj][m][0], v1 = acc[ai][bj][m][1];
                    const bool ropeable = (c32 < 640) || (c32 >= 768 && c32 < 1344);
                    if (ropeable && (c32 & 63) == 0) {
                        f32x4 p0, p1;
#pragma unroll
                        for (int j = 0; j < 4; ++j) { p0[j] = __shfl_xor(v0[j], 16); p1[j] = __shfl_xor(v1[j], 16); }
                        if (fq < 2) {
                            const f32x4 c0 = *(const f32x4*)(rt + pos * 16), c1 = *(const f32x4*)(rt + pos * 16 + 4);
                            const f32x4 s0 = *(const f32x4*)(rt + pos * 16 + 8), s1 = *(const f32x4*)(rt + pos * 16 + 12);
                            const float sg = fq == 0 ? -1.f : 1.f;
#pragma unroll
                            for (int j = 0; j < 4; ++j) { v0[j] = v0[j] * c0[j] + sg * p0[j] * s0[j]; v1[j] = v1[j] * c1[j] + sg * p1[j] * s1[j]; }
                        }
                    }
                    if (c32 < 512) {
                        st_bf8((bf16_t*)(ws + W_Q) + (size_t)tok * 512 + c32 + cl, v0, v1);
                    } else if (c32 < 640) {
                        const int c = c32 - 512 + cl;
                        st_bf8((bf16_t*)(ws + (smp ? W_KS : W_KP)) + kf_index(b * 2 + (c >> 6), smp ? 34 : 64, pos, c & 63), v0, v1);
                        float* o = P.out + (smp ? O_KS + (size_t)st * 128 : O_KP + (size_t)tok * 128) + c;
                        *(f32x4*)o = v0; *(f32x4*)(o + 4) = v1;
                    } else if (c32 < 768) {
                        const int c = c32 - 640 + cl;
                        float* o = P.out + (smp ? O_VS + (size_t)st * 128 : O_VP + (size_t)tok * 128) + c;
                        *(f32x4*)o = v0; *(f32x4*)(o + 4) = v1;
                        bf16_t* vt = (bf16_t*)(ws + (smp ? W_VTS : W_VTP)) + vf_index(b * 2 + (c >> 6), smp ? 34 : 64, pos, c & 63);
#pragma unroll
                        for (int e = 0; e < 4; ++e) {
                            vt[e * 8] = f2bf(v0[e]);
                            vt[(4 + e) * 8] = f2bf(v1[e]);
                        }
                    } else if (c32 < 1280) {
                        st_bf8((bf16_t*)(ws + W_QI) + (size_t)tok * 512 + (c32 - 768) + cl, v0, v1);
                    } else if (c32 < 1344) {
                        const int c = c32 - 1280 + cl;
                        st_bf8((bf16_t*)(ws + (smp ? W_KIS : W_KIP)) + kf_index(b, smp ? 34 : 64, pos, c), v0, v1);
                        float* o = P.out + (smp ? O_KIS + (size_t)st * 64 : O_KIP + (size_t)tok * 64) + c;
                        *(f32x4*)o = v0; *(f32x4*)(o + 4) = v1;
                    } else if (c32 < 1376) {
                        if (fq == 0) {
                            const float sc = 0.35355339059327373f;
                            float* o = (float*)(ws + W_WI) + (size_t)tok * 8;
                            *(f32x4*)o = v0 * sc; *(f32x4*)(o + 4) = v1 * sc;
                        }
                    } else if (c32 < 1920) {
                        st_bf8((bf16_t*)(ws + W_GA) + (size_t)tok * 512 + (c32 - 1408) + cl, act4<1>(v0), act4<1>(v1));
                    } else if (c32 < 2432) {
                        st_bf8((bf16_t*)(ws + W_U) + (size_t)tok * 512 + (c32 - 1920) + cl, v0, v1);
                    } else if (c32 < 2944) {
                        st_bf8((bf16_t*)(ws + W_GS) + (size_t)tok * 512 + (c32 - 2432) + cl, act4<1>(v0), act4<1>(v1));
                    } else if (c32 < 3968) {
                        st_bf8((bf16_t*)(ws + W_MA) + (size_t)tok * 1024 + (c32 - 2944) + cl, act4<2>(v0), act4<2>(v1));
                    } else {
                        st_bf8((bf16_t*)(ws + W_MB) + (size_t)tok * 1024 + (c32 - 3968) + cl, act4<2>(v0), act4<2>(v1));
                    }
                }
        }
    }
};
__device__ __forceinline__ void phase2(const Params& P, char* smem) {
    pg8::StaticOrder S; S.init(NTOK, NINP2, (int)gridDim.x, (int)blockIdx.x);
    pg8::Gemm g{(const bf16_t*)(P.ws + W_H), (const bf16_t*)(P.ws + W_WTIN), NTOK, NINP2, 1024};
    EpiIn E{P};
    pg8::gemm_phase(( PG8_LAS unsigned char*)smem, g, S, E);
}

__device__ __forceinline__ void phase3(const Params& P, char* smem) {
    const int tid = threadIdx.x, lane = tid & 63, wave = tid >> 6, l32 = lane & 31, hh = lane >> 5;
    char* ws = P.ws;
    const bf16_t* U = (const bf16_t*)(ws + W_U);
    const bf16_t* WE = (const bf16_t*)(ws + W_WE);
    const float* A32 = (const float*)(ws + W_A32);
    float* HIN = (float*)(ws + W_E);
    for (int task = blockIdx.x * 8 + wave; task < 1024 + 64; task += gridDim.x * 8) {
        if (task < 1024) {
            const int sp = task & 1, g = (task >> 1) & 31, b = task >> 6;
            f32x16 acc[2][2];
#pragma unroll
            for (int rt = 0; rt < 2; ++rt)
#pragma unroll
                for (int c2 = 0; c2 < 2; ++c2)
#pragma unroll
                    for (int e = 0; e < 16; ++e) acc[rt][c2][e] = 0.f;
            const int sc0 = 32 * ((l32 >> 2) & 1) + 4 * (l32 >> 3) + (l32 & 3);
            const bf16_t* up0 = U + ((size_t)b * 2048 + (size_t)sc0 * 32) * 512 + g * 16 + 8 * hh;
            const bf16_t* up1 = up0 + (size_t)16 * 32 * 512;
            const bf16_t* wp = WE + ((size_t)g * 128 + sp * 32 + l32) * 512 + 8 * hh;
#pragma unroll 8
            for (int ks = 0; ks < 32; ++ks) {
                const bf16x8 a0 = *(const bf16x8*)(up0 + (size_t)ks * 512);
                const bf16x8 a1 = *(const bf16x8*)(up1 + (size_t)ks * 512);
#pragma unroll
                for (int c2 = 0; c2 < 2; ++c2) {
                    const bf16x8 bfr = *(const bf16x8*)(wp + (size_t)c2 * 64 * 512 + ks * 16);
                    acc[0][c2] = MFMA32(a0, bfr, acc[0][c2]);
                    acc[1][c2] = MFMA32(a1, bfr, acc[1][c2]);
                }
            }
            const int p = 32 * sp + l32, gp = g * 64 + p;
            const float a32r = A32[gp * 2], a32i = A32[gp * 2 + 1];
            float sr = 0.f, si = 0.f;
#pragma unroll
            for (int pass = 0; pass < 2; ++pass) {
                float hr = sr, hi = si;
#pragma unroll
                for (int rt = 0; rt < 2; ++rt)
#pragma unroll
                    for (int e = 0; e < 16; ++e) {
                        if (hh == pass) {
                            float* o = HIN + (((size_t)b * 64 + 32 * hh + 16 * rt + e) * 32 + g) * 128 + p;
                            o[0] = hr; o[64] = hi;
                        }
                        const float nr = a32r * hr - a32i * hi + acc[rt][0][e];
                        const float ni = a32r * hi + a32i * hr + acc[rt][1][e];
                        hr = nr; hi = ni;
                    }
                if (pass == 0) { sr = __shfl(hr, l32); si = __shfl(hi, l32); }
            }
        } else {
            const int sp = (task - 1024) & 1, g = (task - 1024) >> 1;
            f32x16 acc[2];
#pragma unroll
            for (int c2 = 0; c2 < 2; ++c2)
#pragma unroll
                for (int e = 0; e < 16; ++e) acc[c2][e] = 0.f;
            const bf16_t* up = U + ((size_t)NP + (size_t)l32 * 64) * 512 + g * 16 + 8 * hh;
            const bf16_t* wp = WE + ((size_t)g * 128 + sp * 32 + l32) * 512 + 8 * hh;
#pragma unroll 8
            for (int ks = 0; ks < 32; ++ks) {
                const bf16x8 a = *(const bf16x8*)(up + (size_t)ks * 512);
#pragma unroll
                for (int c2 = 0; c2 < 2; ++c2) {
                    const bf16x8 bfr = *(const bf16x8*)(wp + (size_t)c2 * 64 * 512 + ks * 16);
                    acc[c2] = MFMA32(a, bfr, acc[c2]);
                }
            }
            const int p = 32 * sp + l32, gp = g * 64 + p;
            const float a32r = A32[gp * 2], a32i = A32[gp * 2 + 1];
#pragma unroll
            for (int e = 0; e < 16; ++e) {
                const int bb = 8 * (e >> 2) + 4 * hh + (e & 3);
                const float h0r = P.st_re[(size_t)(bb * 32 + g) * 64 + p], h0i = P.st_im[(size_t)(bb * 32 + g) * 64 + p];
                float* o = HIN + (((size_t)1024 + bb) * 32 + g) * 128 + p;
                o[0] = a32r * h0r - a32i * h0i + acc[0][e];
                o[64] = a32r * h0i + a32i * h0r + acc[1][e];
            }
        }
    }
}

__device__ __forceinline__ void attn_task(const Params& P, int task, char* smem, bool dummy_out = false) {
    const int tid = threadIdx.x, lane = tid & 63, wave = tid >> 6, l32 = lane & 31, hh = lane >> 5;
    char* ws = P.ws;
    int tok0, L, n_adm;
    const bf16_t *KIb, *Kb, *Vtb;
    if (task < 2048) {
        const int qt = 127 - (task >> 4), b = task & 15;
        tok0 = b * 2048 + qt * 16; L = 2048; n_adm = ((qt >> 2) + 1) * 64;
        KIb = (const bf16_t*)(ws + W_KIP) + (size_t)b * 2048 * 64;
        Kb = (const bf16_t*)(ws + W_KP) + (size_t)b * 2048 * 128;
        Vtb = (const bf16_t*)(ws + W_VTP) + (size_t)b * 128 * 2048;
    } else {
        const int s = task - 2048, b = s >> 2, qt = s & 3;
        tok0 = NP + b * 64 + qt * 16; L = 1088; n_adm = 1088;
        KIb = (const bf16_t*)(ws + W_KIS) + (size_t)b * 1088 * 64;
        Kb = (const bf16_t*)(ws + W_KS) + (size_t)b * 1088 * 128;
        Vtb = (const bf16_t*)(ws + W_VTS) + (size_t)b * 128 * 1088;
    }
    const int ntile = n_adm >> 5;
    float* sc = (float*)smem;
    bf16x8 bq[4];
    {
        const bf16_t* Q = (const bf16_t*)(ws + W_Q);
        const int g3 = wave >> 2, qh3 = (wave >> 1) & 1;
        const int q3 = qh3 * 8 + (l32 >> 2), head3 = g3 * 4 + (l32 & 3);
#pragma unroll
        for (int ks = 0; ks < 4; ++ks) bq[ks] = *(const bf16x8*)(Q + (size_t)(tok0 + q3) * 512 + head3 * 64 + 32 * hh + 8 * ks);
    }
    {
        const bf16_t* QI = (const bf16_t*)(ws + W_QI);
        const float* WI = (const float*)(ws + W_WI);
        const int rg = wave >> 2, kq = wave & 3;
        bf16x8 aq[2][4];
        float wreg[2][16];
#pragma unroll
        for (int rt = 0; rt < 2; ++rt) {
            const int i = l32 >> 3, hR = (l32 >> 2) & 1, j = l32 & 3;
            const int q = rg * 8 + rt * 4 + 2 * hR + (i >> 1), head = 4 * (i & 1) + j;
#pragma unroll
            for (int ks = 0; ks < 4; ++ks) aq[rt][ks] = *(const bf16x8*)(QI + (size_t)(tok0 + q) * 512 + head * 64 + 32 * hh + 8 * ks);
#pragma unroll
            for (int qq = 0; qq < 2; ++qq) {
                const float* wp = WI + (size_t)(tok0 + rg * 8 + rt * 4 + 2 * hh + qq) * 8;
                const f32x4 w0 = *(const f32x4*)wp, w1 = *(const f32x4*)(wp + 4);
#pragma unroll
                for (int j = 0; j < 4; ++j) { wreg[rt][8 * qq + j] = w0[j] * 0.125f; wreg[rt][8 * qq + 4 + j] = w1[j] * 0.125f; }
            }
        }
        bf16x8 nb[4];
        if (kq < ntile) {
#pragma unroll
            for (int ks = 0; ks < 4; ++ks) nb[ks] = *(const bf16x8*)(KIb + ((size_t)(kq * 4 + ks) * 64 + lane) * 8);
        }
        for (int kt = kq; kt < ntile; kt += 4) {
            const int key = kt * 32 + l32;
            bf16x8 bk[4];
#pragma unroll
            for (int ks = 0; ks < 4; ++ks) bk[ks] = nb[ks];
            if (kt + 4 < ntile) {
#pragma unroll
                for (int ks = 0; ks < 4; ++ks) nb[ks] = *(const bf16x8*)(KIb + ((size_t)((kt + 4) * 4 + ks) * 64 + lane) * 8);
            }
#pragma unroll
            for (int rt = 0; rt < 2; ++rt) {
                f32x16 s;
#pragma unroll
                for (int e = 0; e < 16; ++e) s[e] = 0.f;
#pragma unroll
                for (int ks = 0; ks < 4; ++ks) s = MFMA32(aq[rt][ks], bk[ks], s);
                float s0 = 0.f, s1 = 0.f;
#pragma unroll
                for (int e = 0; e < 8; ++e) {
                    s0 += wreg[rt][e] * fmaxf(s[e], 0.f);
                    s1 += wreg[rt][8 + e] * fmaxf(s[8 + e], 0.f);
                }
                const int q0 = rg * 8 + rt * 4 + 2 * hh;
                sc[q0 * SCLD + key] = s0;
                sc[(q0 + 1) * SCLD + key] = s1;
            }
        }
    }
    __syncthreads();
    {
        const int nv = n_adm >> 6;
        const int qa = wave * 2;
        float v[2][32];
#pragma unroll
        for (int i = 0; i < 32; ++i) {
            v[0][i] = (i < nv) ? sc[qa * SCLD + lane + 64 * i] : -3.0e38f;
            v[1][i] = (i < nv) ? sc[(qa + 1) * SCLD + lane + 64 * i] : -3.0e38f;
        }
        float thr[2] = {-3.0e38f, -3.0e38f};
        if (n_adm > 256) {
#define COUNT_GE(Q, T, OUT) do { int _c = 0; _Pragma("unroll") for (int i = 0; i < 32; ++i) _c += (v[Q][i] >= (T)) ? 1 : 0; \
        int _t = 0; _Pragma("unroll") for (int bb = 0; bb < 6; ++bb) _t += __popcll(__ballot((_c >> bb) & 1)) << bb; (OUT) = _t; } while (0)
            float lo[2], hi[2], mid[2], tprev[2], dens[2];
            int clo[2], chi[2], cprev[2];
            bool done[2];
            const float fn = (float)n_adm;
            const float pq = 256.f / fn;
            const float pt = pq <= 0.5f ? pq : 1.f - pq;
            const float tt = sqrtf(-2.f * __logf(pt));
            float z = tt - (2.30753f + 0.27061f * tt) / (1.f + 0.99229f * tt + 0.04481f * tt * tt);
            if (pq > 0.5f) z = -z;
            const float dz = fn * __expf(-0.5f * z * z) * 0.39894228f;
#pragma unroll
            for (int qq = 0; qq < 2; ++qq) {
                float mx = -3.0e38f, mn = 3.0e38f, s1 = 0.f, s2 = 0.f;
#pragma unroll
                for (int i = 0; i < 32; ++i) {
                    const bool ok = v[qq][i] > -1.0e38f;
                    const float x = ok ? v[qq][i] : 0.f;
                    mx = fmaxf(mx, v[qq][i]); mn = fminf(mn, ok ? v[qq][i] : 3.0e38f);
                    s1 += x; s2 += x * x;
                }
#pragma unroll
                for (int o = 32; o >= 1; o >>= 1) {
                    mx = fmaxf(mx, __shfl_xor(mx, o)); mn = fminf(mn, __shfl_xor(mn, o));
                    s1 += __shfl_xor(s1, o); s2 += __shfl_xor(s2, o);
                }
                int c;
                COUNT_GE(qq, mx, c);
                const float mean = s1 * frcp(fn);
                const float sd = sqrtf(fmaxf(s2 * frcp(fn) - mean * mean, 1e-20f));
                lo[qq] = mn; hi[qq] = mx; clo[qq] = n_adm; chi[qq] = c;
                mid[qq] = mean + z * sd; tprev[qq] = 0.f; cprev[qq] = 256;
                dens[qq] = dz * frcp(sd);
                done[qq] = (c >= 256);
                thr[qq] = done[qq] ? mx : mn;
            }
            for (int it = 0; it < 64 && !(done[0] && done[1]); ++it) {
#pragma unroll
                for (int qq = 0; qq < 2; ++qq) {
                    const float interp = lo[qq] + (hi[qq] - lo[qq]) * ((float)(clo[qq] - 256) * frcp((float)(clo[qq] - chi[qq])));
                    const float bis = 0.5f * (lo[qq] + hi[qq]);
                    float md = mid[qq];
                    if (it == 1) { md = tprev[qq] + (float)(cprev[qq] - 256) * frcp(dens[qq]); if (!(md > lo[qq] && md < hi[qq])) md = interp; }
                    else if (it >= 2) md = (it % 3 != 0) ? interp : bis;
                    if (!(md > lo[qq] && md < hi[qq])) md = bis;
                    mid[qq] = md;
                }
                int cc0 = 0, cc1 = 0;
                COUNT_GE(0, mid[0], cc0);
                COUNT_GE(1, mid[1], cc1);
#pragma unroll
                for (int qq = 0; qq < 2; ++qq) {
                    const int cc = qq ? cc1 : cc0;
                    if (!done[qq]) {
                        const float md = mid[qq];
                        if (!(md > lo[qq] && md < hi[qq])) { thr[qq] = lo[qq]; done[qq] = true; }
                        else if (cc == 256) { thr[qq] = md; done[qq] = true; }
                        else {
                            tprev[qq] = md; cprev[qq] = cc;
                            if (cc > 256) { lo[qq] = md; clo[qq] = cc; } else { hi[qq] = md; chi[qq] = cc; }
                            thr[qq] = lo[qq];
                        }
                    }
                }
            }
#undef COUNT_GE
        }
#pragma unroll
        for (int i = 0; i < 32; ++i)
            if (i < nv) {
                sc[qa * SCLD + lane + 64 * i] = (v[0][i] >= thr[0]) ? 0.f : -1.0e30f;
                sc[(qa + 1) * SCLD + lane + 64 * i] = (v[1][i] >= thr[1]) ? 0.f : -1.0e30f;
            }
    }
    __syncthreads();
    {
        const int g = wave >> 2, qh = (wave >> 1) & 1, ksp = wave & 1;
        const int q = qh * 8 + (l32 >> 2), head = g * 4 + (l32 & 3);
        f32x16 o[2];
#pragma unroll
        for (int e = 0; e < 16; ++e) { o[0][e] = 0.f; o[1][e] = 0.f; }
        float m = -3.0e38f, lsum = 0.f;
        const float c1 = 0.125f * 1.44269504f;
        const bf16_t* Kg = Kb + (size_t)g * L * 64;
        const bf16_t* Vg = Vtb + (size_t)g * L * 64;
        bf16x8 nk[4], nv[2][2];
        if (ksp < ntile) {
#pragma unroll
            for (int ks = 0; ks < 4; ++ks) nk[ks] = *(const bf16x8*)(Kg + ((size_t)(ksp * 4 + ks) * 64 + lane) * 8);
#pragma unroll
            for (int s2 = 0; s2 < 2; ++s2)
#pragma unroll
                for (int dt = 0; dt < 2; ++dt) nv[dt][s2] = *(const bf16x8*)(Vg + ((size_t)((ksp * 2 + s2) * 2 + dt) * 64 + lane) * 8);
        }
        for (int kt = ksp; kt < ntile; kt += 2) {
            bf16x8 ak[4], av[2][2];
#pragma unroll
            for (int ks = 0; ks < 4; ++ks) ak[ks] = nk[ks];
#pragma unroll
            for (int s2 = 0; s2 < 2; ++s2)
#pragma unroll
                for (int dt = 0; dt < 2; ++dt) av[dt][s2] = nv[dt][s2];
            if (kt + 2 < ntile) {
                const int kn = kt + 2;
#pragma unroll
                for (int ks = 0; ks < 4; ++ks) nk[ks] = *(const bf16x8*)(Kg + ((size_t)(kn * 4 + ks) * 64 + lane) * 8);
#pragma unroll
                for (int s2 = 0; s2 < 2; ++s2)
#pragma unroll
                    for (int dt = 0; dt < 2; ++dt) nv[dt][s2] = *(const bf16x8*)(Vg + ((size_t)((kn * 2 + s2) * 2 + dt) * 64 + lane) * 8);
            }
            f32x16 s;
#pragma unroll
            for (int e = 0; e < 16; ++e) s[e] = 0.f;
#pragma unroll
            for (int ks = 0; ks < 4; ++ks) s = MFMA32(ak[ks], bq[ks], s);
            f32x2 t2[8];
#pragma unroll
            for (int i = 0; i < 4; ++i) {
                const f32x4 bi = *(const f32x4*)(sc + q * SCLD + kt * 32 + 8 * i + 4 * hh);
                t2[2 * i] = (f32x2){s[4 * i], s[4 * i + 1]} * c1 + (f32x2){bi[0], bi[1]};
                t2[2 * i + 1] = (f32x2){s[4 * i + 2], s[4 * i + 3]} * c1 + (f32x2){bi[2], bi[3]};
            }
            float mloc = fmaxf(fmaxf(t2[0].x, t2[0].y), fmaxf(t2[1].x, t2[1].y));
#pragma unroll
            for (int i = 2; i < 8; i += 2) mloc = fmaxf(mloc, fmaxf(fmaxf(t2[i].x, t2[i].y), fmaxf(t2[i + 1].x, t2[i + 1].y)));
            mloc = fmaxf(mloc, __shfl_xor(mloc, 32));
            if (__ballot(mloc > m + 8.f) != 0ull) {
                const float mnew = (mloc > m + 8.f) ? mloc : m;
                const float alpha = fexp2(m - mnew);
                m = mnew;
                lsum *= alpha;
                const f32x2 al2 = (f32x2){alpha, alpha};
#pragma unroll
                for (int e = 0; e < 16; e += 2) {
                    f32x2 a0 = (f32x2){o[0][e], o[0][e + 1]} * al2, a1 = (f32x2){o[1][e], o[1][e + 1]} * al2;
                    o[0][e] = a0.x; o[0][e + 1] = a0.y; o[1][e] = a1.x; o[1][e + 1] = a1.y;
                }
            }
            const f32x2 m2 = (f32x2){m, m};
            f32x2 ps2 = (f32x2){0.f, 0.f};
#pragma unroll
            for (int i = 0; i < 8; ++i) {
                const f32x2 d = t2[i] - m2;
                f32x2 pe; pe.x = fexp2(d.x); pe.y = fexp2(d.y);
                ps2 += pe;
                s[2 * i] = pe.x; s[2 * i + 1] = pe.y;
            }
            lsum += ps2.x + ps2.y;
            bf16x8 pb[2];
#pragma unroll
            for (int s2 = 0; s2 < 2; ++s2) {
                union { uint4 u; bf16x8 v; } cv;
                cv.u = make_uint4(pack2(s[8 * s2], s[8 * s2 + 1]), pack2(s[8 * s2 + 2], s[8 * s2 + 3]),
                                  pack2(s[8 * s2 + 4], s[8 * s2 + 5]), pack2(s[8 * s2 + 6], s[8 * s2 + 7]));
                pb[s2] = cv.v;
            }
#pragma unroll
            for (int dt = 0; dt < 2; ++dt)
#pragma unroll
                for (int s2 = 0; s2 < 2; ++s2) o[dt] = MFMA32(av[dt][s2], pb[s2], o[dt]);
        }
        lsum += __shfl_xor(lsum, 32);
        __syncthreads();
        float* cb = (float*)smem + (wave >> 1) * (64 * 34);
        if (ksp == 1) {
            cb[lane] = m; cb[64 + lane] = lsum;
#pragma unroll
            for (int dt = 0; dt < 2; ++dt)
#pragma unroll
                for (int e = 0; e < 16; ++e) cb[(2 + dt * 16 + e) * 64 + lane] = o[dt][e];
        }
        __syncthreads();
        if (ksp == 0) {
            const float m1 = cb[lane], l1 = cb[64 + lane];
            const float mm = fmaxf(m, m1);
            const float a0 = fexp2(m - mm), a1 = fexp2(m1 - mm);
            const float inv = 1.f / (lsum * a0 + l1 * a1);
            bf16_t* GA = (bf16_t*)(ws + W_GA);
#pragma unroll
            for (int dt = 0; dt < 2; ++dt)
#pragma unroll
                for (int i = 0; i < 4; ++i) {
                    bf16_t* gp = GA + (size_t)(tok0 + q) * 512 + head * 64 + dt * 32 + 8 * i + 4 * hh;
                    const uint2 gv = *(const uint2*)gp;
                    float r[4];
#pragma unroll
                    for (int j = 0; j < 4; ++j) r[j] = (o[dt][4 * i + j] * a0 + cb[(2 + dt * 16 + 4 * i + j) * 64 + lane] * a1) * inv;
                    bf16_t* op = dummy_out ? (bf16_t*)(ws + W_H + (size_t)NTOK * 1024) + (gp - GA) : gp;
                    st_bf4(op, r[0] * bflo(gv.x), r[1] * bfhi(gv.x), r[2] * bflo(gv.y), r[3] * bfhi(gv.y));
                }
        }
        __syncthreads();
    }
}

__device__ __forceinline__ void ssm_task(const Params& P, int task, char* hs  ) {
    const int lane = threadIdx.x & 63, l32 = lane & 31, hh = lane >> 5;
    char* ws = P.ws;
    const bf16_t* U = (const bf16_t*)(ws + W_U);
    const float* E = (const float*)(ws + W_E);
    const float* A1 = (const float*)(ws + W_A1);
    bool smp; int b, g, j64, tb;
    if (task < 16384) { smp = false; g = task & 31; j64 = (task >> 5) & 31; b = task >> 10; tb = b * 2048 + j64 * 64; }
    else { const int s = task - 16384; smp = true; g = s & 31; b = s >> 5; j64 = 0; tb = NP + b * 64; }
    f32x16 bu[2][4];
    {
        bf16x8 au[2], bb[4];
#pragma unroll
        for (int rt = 0; rt < 2; ++rt) {
            const int tau = 32 * ((l32 >> 2) & 1) + 16 * rt + 4 * (l32 >> 3) + (l32 & 3);
            au[rt] = *(const bf16x8*)(U + (size_t)(tb + tau) * 512 + g * 16 + 8 * hh);
        }
        const bf16_t* Bt = (const bf16_t*)(ws + W_BT);
#pragma unroll
        for (int ct = 0; ct < 4; ++ct) bb[ct] = *(const bf16x8*)(Bt + ((size_t)g * 128 + ct * 32 + l32) * 16 + 8 * hh);
        f32x16 z;
#pragma unroll
        for (int e = 0; e < 16; ++e) z[e] = 0.f;
#pragma unroll
        for (int rt = 0; rt < 2; ++rt)
#pragma unroll
            for (int ct = 0; ct < 4; ++ct) bu[rt][ct] = MFMA32(au[rt], bb[ct], z);
    }
    float cr[2], ci[2];
#pragma unroll
    for (int sp = 0; sp < 2; ++sp) {
        const int p = 32 * sp + l32;
        if (!smp) {
            const float* ep = E + (((size_t)b * 64 + 2 * j64 + hh) * 32 + g) * 128 + p;
            cr[sp] = ep[0]; ci[sp] = ep[64];
        } else {
            const float* ep = E + (((size_t)1024 + b) * 32 + g) * 128 + p;
            const float* h0r = P.st_re + (size_t)(b * 32 + g) * 64 + p;
            const float* h0i = P.st_im + (size_t)(b * 32 + g) * 64 + p;
            cr[sp] = hh ? ep[0] : h0r[0];
            ci[sp] = hh ? ep[64] : h0i[0];
        }
    }
#pragma unroll
    for (int sp = 0; sp < 2; ++sp) {
        const int p = 32 * sp + l32, gp = g * 64 + p;
        const float ar = A1[gp * 2], ai = A1[gp * 2 + 1];
        float hr = cr[sp], hi = ci[sp];
#pragma unroll
        for (int rt = 0; rt < 2; ++rt)
#pragma unroll
            for (int e = 0; e < 16; ++e) {
                const float nr = ar * hr - ai * hi + bu[rt][sp][e];
                const float ni = ar * hi + ai * hr + bu[rt][sp + 2][e];
                hr = nr; hi = ni;
                bu[rt][sp][e] = hr; bu[rt][sp + 2][e] = hi;
            }
        if (hh == 1 && (smp || j64 == 31)) {
            float* ore = P.out + (smp ? O_HRS : O_HRP) + (size_t)(b * 32 + g) * 64 + p;
            float* oim = P.out + (smp ? O_HIS : O_HIP) + (size_t)(b * 32 + g) * 64 + p;
            *ore = hr; *oim = hi;
        }
    }
    asm volatile("s_waitcnt lgkmcnt(0)" ::: "memory");
#pragma unroll
    for (int rt = 0; rt < 2; ++rt)
#pragma unroll
        for (int e = 0; e < 16; ++e) {
            const int tau = 32 * hh + 16 * rt + e;
            uint2 v; v.x = pack2(bu[rt][0][e], bu[rt][1][e]); v.y = pack2(bu[rt][2][e], bu[rt][3][e]);
            *(uint2*)(hs + tau * 272 + l32 * 8) = v;
        }
    asm volatile("s_waitcnt lgkmcnt(0)" ::: "memory");
    __builtin_amdgcn_wave_barrier();
    {
        const bf16_t* Cc = (const bf16_t*)(ws + W_CC);
        bf16_t* YG = (bf16_t*)(ws + W_H);
        const int l16 = lane & 15, lq = lane >> 4;
        bf16x8 cc[4];
#pragma unroll
        for (int ks = 0; ks < 4; ++ks) cc[ks] = *(const bf16x8*)(Cc + ((size_t)g * 16 + l16) * 128 + 32 * ks + 8 * lq);
        const int ch = g * 16 + l16;
        const float dsk = P.d_skip[ch];
#pragma unroll
        for (int r16 = 0; r16 < 4; ++r16) {
            f32x4 y = {0.f, 0.f, 0.f, 0.f};
#pragma unroll
            for (int ks = 0; ks < 4; ++ks) {
                const bf16x8 a = *(const bf16x8*)(hs + (16 * r16 + l16) * 272 + (32 * ks + 8 * lq) * 2);
                y = MFMA16(a, cc[ks], y);
            }
#pragma unroll
            for (int j = 0; j < 4; ++j) {
                const size_t idx = (size_t)(tb + 16 * r16 + 4 * lq + j) * 512 + ch;
                const float u = bf2f(U[idx]);
                YG[idx] = f2bf(geluf_(y[j] + dsk * u));
            }
        }
    }
    asm volatile("s_waitcnt lgkmcnt(0)" ::: "memory");
    __builtin_amdgcn_wave_barrier();
}

__device__ __forceinline__ void phase4(const Params& P, char* smem, bool dummy_out = false) {
    const int tid = threadIdx.x, lane = tid & 63, wave = tid >> 6;
    unsigned* cnt = (unsigned*)(P.ws + W_CNT);
    int* slot = (int*)(smem + 16 * SCLD * 4);
    int pend = 0;
    if (tid == 0) pend = (int)atomicAdd(cnt + 0, 1u);
    for (;;) {
        if (tid == 0) *slot = pend;
        __syncthreads();
        const int task = *slot;
        if (task >= 2048 + 128) break;
        if (tid == 0) pend = (int)atomicAdd(cnt + 0, 1u);
        attn_task(P, task, smem, dummy_out);
    }
    __syncthreads();
    char* hs = smem + wave * 17408;
    int nextc = 0;
    if (lane == 0) nextc = (int)atomicAdd(cnt + 16, 1u);
    for (;;) {
        const int chunk = __shfl(nextc, 0);
        if (chunk >= (16384 + 1024) / 4) break;
        if (lane == 0) nextc = (int)atomicAdd(cnt + 16, 1u);
        for (int i = 0; i < 4; ++i) ssm_task(P, chunk * 4 + i, hs);
    }
}

struct EpiGlu {
    Params P;
    __device__ __forceinline__ void operator()(const f32x4 (&acc)[2][2][4][2], const pg8::Unit& u, int wr, int wc, int fr, int fq) const {
        const bf16_t* GS = (const bf16_t*)(P.ws + W_GS);
        bf16_t* T2 = (bf16_t*)(P.ws + W_U);
        uint2 gv[2][4][2];
#pragma unroll
        for (int ai = 0; ai < 2; ++ai)
#pragma unroll
            for (int m = 0; m < 4; ++m)
#pragma unroll
                for (int bj = 0; bj < 2; ++bj) {
                    const int tok = u.pm * 256 + ai * 128 + wr * 64 + m * 16 + fr;
                    gv[ai][m][bj] = *(const uint2*)(GS + (size_t)tok * 512 + u.pn * 128 + bj * 64 + wc * 16 + 4 * fq);
                }
#pragma unroll
        for (int ai = 0; ai < 2; ++ai)
#pragma unroll
            for (int m = 0; m < 4; ++m)
#pragma unroll
                for (int bj = 0; bj < 2; ++bj) {
                    const int tok = u.pm * 256 + ai * 128 + wr * 64 + m * 16 + fr;
                    const size_t idx = (size_t)tok * 512 + u.pn * 128 + bj * 64 + wc * 16 + 4 * fq;
                    const uint2 g = gv[ai][m][bj];
                    const f32x4 va = acc[ai][bj][m][0], ga = act4<2>(acc[ai][bj][m][1]);
                    st_bf4(T2 + idx, va[0] * ga[0] * bflo(g.x), va[1] * ga[1] * bfhi(g.x), va[2] * ga[2] * bflo(g.y), va[3] * ga[3] * bfhi(g.y));
                }
    }
};
__device__ __forceinline__ void phase5(const Params& P, char* smem);
template <int PART>
struct EpiMerge {
    Params P;
    __device__ __forceinline__ void operator()(const f32x4 (&acc)[2][2][4][2], const pg8::Unit& u, int wr, int wc, int fr, int fq) const {
        const bf16_t* MX = (const bf16_t*)(P.ws + (PART == 0 ? W_MA : W_MB));
        bf16_t* MG = (bf16_t*)(P.ws + W_Q);
#pragma unroll
        for (int ai = 0; ai < 2; ++ai) {
            uint4 mv[4][2], pv[4][2];
#pragma unroll
            for (int m = 0; m < 4; ++m)
#pragma unroll
                for (int bj = 0; bj < 2; ++bj) {
                    const int tok = u.pm * 256 + ai * 128 + wr * 64 + m * 16 + fr;
                    const size_t idx = (size_t)tok * 1024 + u.pn * 256 + bj * 128 + wc * 32 + 8 * fq;
                    mv[m][bj] = *(const uint4*)(MX + idx);
                    if (PART == 1) pv[m][bj] = *(const uint4*)(MG + idx);
                }
#pragma unroll
            for (int m = 0; m < 4; ++m)
#pragma unroll
                for (int bj = 0; bj < 2; ++bj) {
                    const int tok = u.pm * 256 + ai * 128 + wr * 64 + m * 16 + fr;
                    const size_t idx = (size_t)tok * 1024 + u.pn * 256 + bj * 128 + wc * 32 + 8 * fq;
                    const uint4 a = mv[m][bj];
                    f32x4 r0 = acc[ai][bj][m][0], r1 = acc[ai][bj][m][1];
                    r0[0] *= bflo(a.x); r0[1] *= bfhi(a.x); r0[2] *= bflo(a.y); r0[3] *= bfhi(a.y);
                    r1[0] *= bflo(a.z); r1[1] *= bfhi(a.z); r1[2] *= bflo(a.w); r1[3] *= bfhi(a.w);
                    if (PART == 1) {
                        const uint4 b = pv[m][bj];
                        r0[0] += bflo(b.x); r0[1] += bfhi(b.x); r0[2] += bflo(b.y); r0[3] += bfhi(b.y);
                        r1[0] += bflo(b.z); r1[1] += bfhi(b.z); r1[2] += bflo(b.w); r1[3] += bfhi(b.w);
                    }
                    st_bf8(MG + idx, r0, r1);
                }
        }
    }
};
__device__ __forceinline__ void phase5(const Params& P, char* smem) {
    {
        pg8::StaticOrder S; S.init(NTOK, 1024, (int)gridDim.x, (int)blockIdx.x);
        pg8::Gemm g{(const bf16_t*)(P.ws + W_H), (const bf16_t*)(P.ws + W_WTGLU), NTOK, 1024, 512};
        EpiGlu E{P};
        pg8::gemm_phase((PG8_LAS unsigned char*)smem, g, S, E);
    }
    {
        pg8::StaticOrder S; S.init(NTOK, 1024, (int)gridDim.x, (int)(gridDim.x - 1 - blockIdx.x));
        pg8::Gemm g{(const bf16_t*)(P.ws + W_GA), (const bf16_t*)(P.ws + W_WTAP), NTOK, 1024, 512};
        EpiMerge<0> E{P};
        pg8::gemm_phase((PG8_LAS unsigned char*)smem, g, S, E);
    }
}
__device__ __forceinline__ void phase6(const Params& P, char* smem) {
    pg8::StaticOrder S; S.init(NTOK, 1024, (int)gridDim.x, (int)blockIdx.x);
    pg8::Gemm g{(const bf16_t*)(P.ws + W_U), (const bf16_t*)(P.ws + W_WTSP), NTOK, 1024, 512};
    EpiMerge<1> E{P};
    pg8::gemm_phase((PG8_LAS unsigned char*)smem, g, S, E);
}

struct EpiOut {
    Params P;
    __device__ __forceinline__ void operator()(const f32x4 (&acc)[2][2][4][2], const pg8::Unit& u, int wr, int wc, int fr, int fq) const {
        const float* modf = (const float*)(P.ws + W_MODF);
#pragma unroll
        for (int ai = 0; ai < 2; ++ai) {
            f32x4 xv[4][2][2];
#pragma unroll
            for (int m = 0; m < 4; ++m) {
                const float* xr = xrow(P, u.pm * 256 + ai * 128 + wr * 64 + m * 16 + fr);
#pragma unroll
                for (int bj = 0; bj < 2; ++bj) {
                    const int n = u.pn * 256 + bj * 128 + wc * 32 + 8 * fq;
                    xv[m][bj][0] = *(const f32x4*)(xr + n); xv[m][bj][1] = *(const f32x4*)(xr + n + 4);
                }
            }
#pragma unroll
            for (int m = 0; m < 4; ++m) {
                const int tok = u.pm * 256 + ai * 128 + wr * 64 + m * 16 + fr;
                const float* gate = modf + (size_t)modrow(tok) * 3072 + 2048;
#pragma unroll
                for (int bj = 0; bj < 2; ++bj) {
                    const int n = u.pn * 256 + bj * 128 + wc * 32 + 8 * fq;
                    const f32x4 g0 = *(const f32x4*)(gate + n), g1 = *(const f32x4*)(gate + n + 4);
                    float* o = P.out + O_Y + (size_t)tok * 1024 + n;
                    *(f32x4*)o = xv[m][bj][0] + g0 * acc[ai][bj][m][0];
                    *(f32x4*)(o + 4) = xv[m][bj][1] + g1 * acc[ai][bj][m][1];
                }
            }
        }
    }
};
__device__ __forceinline__ void phase7(const Params& P, char* smem) {
    pg8::StaticOrder S; S.init(NTOK, 1024, (int)gridDim.x, (int)blockIdx.x);
    pg8::Gemm g{(const bf16_t*)(P.ws + W_Q), (const bf16_t*)(P.ws + W_WTOUT), NTOK, 1024, 1024};
    EpiOut E{P};
    pg8::gemm_phase((PG8_LAS unsigned char*)smem, g, S, E);
}

__device__ __forceinline__ void phase8(const Params& P, char* smem) {
    const int lane = threadIdx.x & 63, wave = threadIdx.x >> 6;
    for (int tok0 = (blockIdx.x * 8 + wave) * 2; tok0 < NTOK; tok0 += gridDim.x * 16) {
        float4 v[2][4];
#pragma unroll
        for (int r = 0; r < 2; ++r)
#pragma unroll
            for (int i = 0; i < 4; ++i) v[r][i] = *(const float4*)(P.out + O_Y + (size_t)(tok0 + r) * 1024 + 4 * lane + 256 * i);
        float4 g4[4];
#pragma unroll
        for (int i = 0; i < 4; ++i) g4[i] = *(const float4*)(P.g_final + 4 * lane + 256 * i);
#pragma unroll
        for (int r = 0; r < 2; ++r) {
            float* y = P.out + O_Y + (size_t)(tok0 + r) * 1024;
            float ss = 0.f;
#pragma unroll
            for (int i = 0; i < 4; ++i) ss += v[r][i].x * v[r][i].x + v[r][i].y * v[r][i].y + v[r][i].z * v[r][i].z + v[r][i].w * v[r][i].w;
#pragma unroll
            for (int o = 32; o >= 1; o >>= 1) ss += __shfl_xor(ss, o);
            const float rinv = rsqrtf(ss * (1.f / 1024.f) + 1e-6f);
#pragma unroll
            for (int i = 0; i < 4; ++i)
                *(float4*)(y + 4 * lane + 256 * i) = make_float4(v[r][i].x * rinv * g4[i].x, v[r][i].y * rinv * g4[i].y, v[r][i].z * rinv * g4[i].z, v[r][i].w * rinv * g4[i].w);
        }
    }
}

#define XB_TMO      128
#define XB_XCNT(j)  (256  + 64 * (j))
#define XB_XSUB(j)  (1280 + 64 * (j))
#define XB_XGEN(j)  (2304 + 64 * (j))
#define XB_TOP      3328
#define XB_TOPGEN   3392
#define XCD_BAR_WORDS 3456
#define XB_SPIN_CAP (1u << 18)
#define LAS __attribute__((address_space(3)))
__device__ __forceinline__ unsigned xb_ld(unsigned* p)              { return __hip_atomic_load(p, __ATOMIC_RELAXED, __HIP_MEMORY_SCOPE_AGENT); }
__device__ __forceinline__ unsigned xb_add(unsigned* p, unsigned v) { return __hip_atomic_fetch_add(p, v, __ATOMIC_RELAXED, __HIP_MEMORY_SCOPE_AGENT); }
__device__ __forceinline__ unsigned xb_xcc_id() { return (unsigned)__builtin_amdgcn_s_getreg((3 << 11) | 20) & 0xFu; }
#define XB_SPIN(cond, bar) do { unsigned _sp = 0; while (cond) { __builtin_amdgcn_s_sleep(1); \
    if ((++_sp & 255u) == 0u) { if (xb_ld(&(bar)[XB_TMO])) break; if (_sp > XB_SPIN_CAP) { atomicAdd(&(bar)[XB_TMO], 1u); break; } } } } while (0)
struct XcdBarrier { unsigned* bar; unsigned x; volatile LAS unsigned* st; };
__device__ __forceinline__ XcdBarrier xcd_barrier_post(unsigned* bar, volatile LAS unsigned* st) {
    XcdBarrier b; b.bar = bar; b.x = xb_xcc_id(); b.st = st;
    if (threadIdx.x == 0) (void)xb_add(&bar[XB_XCNT(b.x)], 1u);
    return b;
}
__device__ __forceinline__ void xcd_barrier_complete(unsigned* bar, unsigned x, unsigned& nloc, unsigned& nx) {
    const unsigned G = gridDim.x * gridDim.y * gridDim.z;
    unsigned sum, cnt, mine, sp = 0u;
    for (;;) {
        sum = 0u; cnt = 0u; mine = 0u;
#pragma unroll
        for (unsigned j = 0; j < 16; ++j) { const unsigned c = xb_ld(&bar[XB_XCNT(j)]); sum += c; cnt += (c > 0u) ? 1u : 0u; mine = (j == x) ? c : mine; }
        if (sum == G) break;
        __builtin_amdgcn_s_sleep(1);
        if ((++sp & 255u) == 0u) { if (xb_ld(&bar[XB_TMO])) break; if (sp > XB_SPIN_CAP) { atomicAdd(&bar[XB_TMO], 1u); break; } }
    }
    nloc = mine > 0u ? mine : 1u; nx = cnt > 0u ? cnt : 1u;
}
__device__ __forceinline__ void xcd_barrier(const XcdBarrier& b) {
    asm volatile("s_waitcnt vmcnt(0)" ::: "memory");
    __syncthreads();
    if (threadIdx.x == 0) {
        unsigned* bar = b.bar;
        __builtin_amdgcn_s_waitcnt(0);
        unsigned nloc = b.st[0], nx = b.st[1];
        if (nloc == 0u) { xcd_barrier_complete(bar, b.x, nloc, nx); b.st[0] = nloc; b.st[1] = nx; }
        const unsigned old = xb_add(&bar[XB_XSUB(b.x)], 1u);
        const unsigned gen = old / nloc;
        if (old + 1u == (gen + 1u) * nloc) {
            __builtin_amdgcn_fence(__ATOMIC_RELEASE, "agent");
            asm volatile("s_waitcnt vmcnt(0)" ::: "memory");
            const unsigned og = xb_add(&bar[XB_TOP], 1u);
            const unsigned tg = og / nx;
            if (og + 1u == (tg + 1u) * nx) xb_add(&bar[XB_TOPGEN], 1u);
            else XB_SPIN(xb_ld(&bar[XB_TOPGEN]) == tg, bar);
            __builtin_amdgcn_fence(__ATOMIC_ACQUIRE, "agent");
            xb_add(&bar[XB_XGEN(b.x)], 1u);
            asm volatile("s_waitcnt vmcnt(0)" ::: "memory");
        } else {
            XB_SPIN(xb_ld(&bar[XB_XGEN(b.x)]) == gen, bar);
            __builtin_amdgcn_fence(__ATOMIC_ACQUIRE, "agent");
            asm volatile("s_waitcnt vmcnt(0)" ::: "memory");
        }
    }
    __syncthreads();
}

extern __shared__ __attribute__((aligned(16))) char dyn_smem[];

#ifndef REP2
#define REP2 0
#endif
#ifndef REP4
#define REP4 0
#endif
#ifndef REPSYNC
#define REPSYNC 1
#endif
#define GSYNC() xcd_barrier(xb)
__global__ void __launch_bounds__(NTHREADS) mega_kernel(Params P) {
    cg::grid_group grid = cg::this_grid();
    volatile LAS unsigned* xst = (volatile LAS unsigned*)(dyn_smem + SMEM_BYTES - 16);
    if (threadIdx.x == 0) { xst[0] = 0u; xst[1] = 0u; }
    __syncthreads();
    XcdBarrier xb = xcd_barrier_post((unsigned*)(P.ws + W_BAR), xst);
    if (P.out == nullptr) grid.sync();
    phase0(P, dyn_smem); GSYNC();
    phase1(P, dyn_smem); GSYNC();
    phase2(P, dyn_smem); GSYNC();
#if REP2
    phase2(P, dyn_smem); GSYNC();
#endif
    phase3(P, dyn_smem); GSYNC();
#if REP4
    phase4(P, dyn_smem, true); GSYNC();
    if (blockIdx.x == 0 && threadIdx.x < 64) ((unsigned*)(P.ws + W_CNT))[threadIdx.x] = 0u;
    GSYNC();
#endif
    phase4(P, dyn_smem); GSYNC();
    phase5(P, dyn_smem); GSYNC();
    phase6(P, dyn_smem); GSYNC();
    phase7(P, dyn_smem); GSYNC();
    phase8(P, dyn_smem);
}

template <int PH>
__global__ void __launch_bounds__(NTHREADS) phase_kernel(Params P) {
    if (PH == 0) phase0(P, dyn_smem);
    if (PH == 1) phase1(P, dyn_smem);
    if (PH == 2) phase2(P, dyn_smem);
    if (PH == 3) phase3(P, dyn_smem);
    if (PH == 4) phase4(P, dyn_smem);
    if (PH == 5) phase5(P, dyn_smem);
    if (PH == 6) phase6(P, dyn_smem);
    if (PH == 7) phase7(P, dyn_smem);
    if (PH == 8) phase8(P, dyn_smem);
}

template <int PH>
static void launch_phase(const Params& p, hipStream_t stream) {
    static bool attr = false;
    if (!attr) { (void)hipFuncSetAttribute((const void*)phase_kernel<PH>, hipFuncAttributeMaxDynamicSharedMemorySize, SMEM_BYTES); attr = true; }
    phase_kernel<PH><<<256, NTHREADS, SMEM_BYTES, stream>>>(p);
}

extern "C" void kernel_launch(void* const* d_in, const int* in_sizes, int n_in, void* d_out, int out_size, void* d_ws, size_t ws_size,
                              hipStream_t stream) {
    Params p{};
    const float* const* in = (const float* const*)d_in;
    p.x_prompt = in[0]; p.x_sample = in[1]; p.cache_k = in[2]; p.cache_v = in[3]; p.cache_idx_k = in[4];
    p.st_re = in[5]; p.st_im = in[6]; p.c_prompt = in[7]; p.c_sample = in[8];
    p.w_mod = in[9]; p.b_mod = in[10]; p.g_norm = in[11]; p.w_in = in[12];
    p.lam_re = in[13]; p.lam_im = in[14]; p.log_dt = in[15]; p.b_re = in[16]; p.b_im = in[17];
    p.c_re = in[18]; p.c_im = in[19]; p.d_skip = in[20]; p.w_glu = in[21]; p.w_ap = in[22]; p.w_sp = in[23];
    p.w_out = in[24]; p.g_final = in[25];
    p.out = (float*)d_out;
    p.ws = (char*)d_ws;
    if (ws_size < W_END) { fprintf(stderr, "workspace too small: %zu < %zu\n", ws_size, (size_t)W_END); return; }
#if MEGA
    static int grid_blocks = 0;
    if (!grid_blocks) {
        (void)hipFuncSetAttribute((const void*)mega_kernel, hipFuncAttributeMaxDynamicSharedMemorySize, SMEM_BYTES);
        int dev = 0, cus = 0, per_cu = 0;
        (void)hipGetDevice(&dev);
        (void)hipDeviceGetAttribute(&cus, hipDeviceAttributeMultiprocessorCount, dev);
        (void)hipOccupancyMaxActiveBlocksPerMultiprocessor(&per_cu, mega_kernel, NTHREADS, SMEM_BYTES);
        if (per_cu > 1) per_cu = 1;
        grid_blocks = cus * per_cu;
    }
    (void)hipMemsetAsync(p.ws + W_CNT, 0, W_WTIN - W_CNT, stream);
    void* args[] = {&p};
    hipError_t e = hipLaunchCooperativeKernel((void*)mega_kernel, dim3(grid_blocks), dim3(NTHREADS), args, SMEM_BYTES, stream);
    if (e != hipSuccess) fprintf(stderr, "cooperative launch failed: %s (grid %d)\n", hipGetErrorString(e), grid_blocks);
#else
    (void)hipMemsetAsync(p.ws + W_CNT, 0, W_WTIN - W_CNT, stream);
#ifndef PROBE_SET
#define PROBE_SET 0
#endif
    launch_phase<0>(p, stream); if (PROBE_SET & 1) launch_phase<0>(p, stream);
    launch_phase<1>(p, stream); if (PROBE_SET & 2) launch_phase<1>(p, stream);
    launch_phase<2>(p, stream); if (PROBE_SET & 4) launch_phase<2>(p, stream);
    launch_phase<3>(p, stream); if (PROBE_SET & 8) launch_phase<3>(p, stream);
    launch_phase<4>(p, stream);
    launch_phase<5>(p, stream); if (PROBE_SET & 32) launch_phase<5>(p, stream);
    launch_phase<6>(p, stream); if (PROBE_SET & 64) launch_phase<6>(p, stream);
    launch_phase<7>(p, stream); if (PROBE_SET & 128) launch_phase<7>(p, stream);
    launch_phase<8>(p, stream);
#endif
}
```

```cpp
#include <hip/hip_runtime.h>
#include <hip/hip_cooperative_groups.h>
#include <cstdio>
namespace cg = cooperative_groups;

#ifndef MEGA
#define MEGA 1
#endif

typedef unsigned short bf16_t;
typedef short bf16x8 __attribute__((ext_vector_type(8)));
typedef float f32x16 __attribute__((ext_vector_type(16)));
typedef float f32x4 __attribute__((ext_vector_type(4)));
typedef float f32x2 __attribute__((ext_vector_type(2)));

constexpr int D = 1024, NP = 32768, NS = 2048, NTOK = NP + NS;
constexpr int NIN = 4936, NINP = 4992, NINP2 = 5120;
constexpr int SCLD = 2056;
constexpr int SMEM_BYTES = 143360;
constexpr int NTHREADS = 512;

constexpr size_t O_Y = 0;
constexpr size_t O_KP = (size_t)NTOK * 1024;
constexpr size_t O_VP = O_KP + (size_t)NP * 128;
constexpr size_t O_KIP = O_VP + (size_t)NP * 128;
constexpr size_t O_HRP = O_KIP + (size_t)NP * 64;
constexpr size_t O_HIP = O_HRP + 16 * 32 * 64;
constexpr size_t O_KS = O_HIP + 16 * 32 * 64;
constexpr size_t O_VS = O_KS + (size_t)NS * 128;
constexpr size_t O_KIS = O_VS + (size_t)NS * 128;
constexpr size_t O_HRS = O_KIS + (size_t)NS * 64;
constexpr size_t O_HIS = O_HRS + 32 * 32 * 64;

constexpr size_t al(size_t x) { return (x + 255) & ~(size_t)255; }
constexpr size_t W_CNT = 0;
constexpr size_t W_BAR = 256;
constexpr size_t W_CNT2 = W_BAR + 3456 * 4;
constexpr size_t W_WTIN = W_CNT2 + 8 * 256;
constexpr size_t W_WTGLU = W_WTIN + al((size_t)NINP2 * 1024 * 2);
constexpr size_t W_WTAP = W_WTGLU + al((size_t)1024 * 512 * 2);
constexpr size_t W_WTSP = W_WTAP + al((size_t)1024 * 512 * 2);
constexpr size_t W_WTOUT = W_WTSP + al((size_t)1024 * 512 * 2);
constexpr size_t W_MODP = W_WTOUT + al((size_t)1024 * 1024 * 2);
constexpr size_t W_MODF = W_MODP + al((size_t)8 * 48 * 3072 * 4);
constexpr size_t W_ROPE = W_MODF + al((size_t)48 * 3072 * 4);
constexpr size_t W_BT = W_ROPE + al((size_t)2048 * 16 * 4);
constexpr size_t W_WE = W_BT + al((size_t)32 * 128 * 16 * 2);
constexpr size_t W_A1 = W_WE + al((size_t)32 * 128 * 512 * 2);
constexpr size_t W_A32 = W_A1 + al((size_t)32 * 64 * 2 * 4);
constexpr size_t W_CC = W_A32 + al((size_t)32 * 64 * 2 * 4);
constexpr size_t W_H = W_CC + al((size_t)32 * 16 * 128 * 2);
constexpr size_t W_Q = W_H + al((size_t)NTOK * 1024 * 2);
constexpr size_t W_QI = W_Q + al((size_t)NTOK * 512 * 2);
constexpr size_t W_WI = W_QI + al((size_t)NTOK * 512 * 2);
constexpr size_t W_KP = W_WI + al((size_t)NTOK * 8 * 4);
constexpr size_t W_VTP = W_KP + al((size_t)NP * 128 * 2);
constexpr size_t W_KIP = W_VTP + al((size_t)NP * 128 * 2);
constexpr size_t W_KS = W_KIP + al((size_t)NP * 64 * 2);
constexpr size_t W_VTS = W_KS + al((size_t)32 * 1088 * 128 * 2);
constexpr size_t W_KIS = W_VTS + al((size_t)32 * 1088 * 128 * 2);
constexpr size_t W_GA = W_KIS + al((size_t)32 * 1088 * 64 * 2);
constexpr size_t W_U = W_GA + al((size_t)NTOK * 512 * 2);
constexpr size_t W_GS = W_U + al((size_t)NTOK * 512 * 2);
constexpr size_t W_MA = W_GS + al((size_t)NTOK * 512 * 2);
constexpr size_t W_MB = W_MA + al((size_t)NTOK * 1024 * 2);
constexpr size_t W_E = W_MB + al((size_t)NTOK * 1024 * 2);
constexpr size_t W_END = W_E + al((size_t)1088 * 32 * 128 * 4);

struct Params {
    const float *x_prompt, *x_sample, *cache_k, *cache_v, *cache_idx_k, *st_re, *st_im, *c_prompt, *c_sample;
    const float *w_mod, *b_mod, *g_norm, *w_in, *lam_re, *lam_im, *log_dt, *b_re, *b_im, *c_re, *c_im, *d_skip;
    const float *w_glu, *w_ap, *w_sp, *w_out, *g_final;
    float* out;
    char* ws;
};

__device__ __forceinline__ unsigned pack2(float lo, float hi) {
    unsigned r;
    asm("v_cvt_pk_bf16_f32 %0, %1, %2" : "=v"(r) : "v"(lo), "v"(hi));
    return r;
}
__device__ __forceinline__ bf16_t f2bf(float f) { return (bf16_t)(pack2(f, 0.f) & 0xffffu); }
__device__ __forceinline__ float bf2f(bf16_t b) { return __uint_as_float(((unsigned)b) << 16); }
__device__ __forceinline__ float bflo(unsigned u) { return __uint_as_float(u << 16); }
__device__ __forceinline__ float bfhi(unsigned u) { return __uint_as_float(u & 0xffff0000u); }
__device__ __forceinline__ float fexp2(float x) { return __builtin_amdgcn_exp2f(x); }
__device__ __forceinline__ float frcp(float x) { return __builtin_amdgcn_rcpf(x); }
__device__ __forceinline__ float sigmoidf_(float x) { return frcp(1.f + fexp2(-1.44269504f * x)); }
__device__ __forceinline__ float siluf_(float x) { return x * sigmoidf_(x); }
__device__ __forceinline__ float geluf_(float x) {
    const float inner = x * (1.f + 0.044715f * x * x);
    return x * frcp(1.f + fexp2(-2.f * 0.7978845608f * 1.44269504f * inner));
}
__device__ __forceinline__ void sincos_big(float ang, float& s, float& c) {
    const float C_HI = 0.15915494309189535f;
    const float C_LO = 6.4206382e-09f;
    float p = ang * C_HI;
    float e = fmaf(ang, C_HI, -p) + ang * C_LO;
    float fr = p - rintf(p);
    fr += e;
    s = __builtin_amdgcn_sinf(fr);
    c = __builtin_amdgcn_cosf(fr);
}
__device__ __forceinline__ const float* xrow(const Params& P, int tok) {
    return tok < NP ? P.x_prompt + (size_t)tok * D : P.x_sample + (size_t)(tok - NP) * D;
}
__device__ __forceinline__ int modrow(int tok) { return tok < NP ? (tok >> 11) : 16 + ((tok - NP) >> 6); }
__device__ __forceinline__ void st_bf4(bf16_t* p, float a, float b, float c, float d) {
    uint2 v; v.x = pack2(a, b); v.y = pack2(c, d);
    *(uint2*)p = v;
}
__device__ __forceinline__ size_t kf_index(int bg, int nt, int key, int d0) {
    return ((((size_t)bg * nt + (key >> 5)) * 4 + ((d0 >> 3) & 3)) * 64 + (d0 >> 5) * 32 + (key & 31)) * 8 + (d0 & 7);
}
__device__ __forceinline__ size_t vf_index(int bg, int nt, int key, int d) {
    const int kk = key & 31, s2 = kk >> 4, r = kk & 15, hh = (r >> 2) & 1, j = (r >> 3) * 4 + (r & 3);
    return (((((size_t)bg * nt + (key >> 5)) * 2 + s2) * 2 + (d >> 5)) * 64 + hh * 32 + (d & 31)) * 8 + j;
}
#define MFMA32(a, b, c) __builtin_amdgcn_mfma_f32_32x32x16_bf16((a), (b), (c), 0, 0, 0)
#define MFMA16(a, b, c) __builtin_amdgcn_mfma_f32_16x16x32_bf16((a), (b), (c), 0, 0, 0)

template <int MODE>
__device__ __forceinline__ int colmap(int n) {
    if (MODE == 0) {
        if (n < 1352) return n;
        if (n < 1408 || n >= NINP) return -1;
        return n - 56;
    } else if (MODE == 1) {
        return (n >> 3) * 4 + ((n & 4) ? 512 : 0);
    } else return n;
}
template <int MODE>
__device__ __forceinline__ void transpose_tiles4(const float* __restrict__ src, int ldsrc, int K, bf16_t* __restrict__ dst, int t0, int ntn, char* smem) {
    const int tid = threadIdx.x;
    float4 v[4][2];
#pragma unroll
    for (int q = 0; q < 4; ++q) {
        const int kt = (t0 + q) / ntn, nt = (t0 + q) % ntn;
#pragma unroll
        for (int i = 0; i < 2; ++i) {
            const int k = (tid >> 4) + 32 * i, n4 = (tid & 15) * 4;
            const int sc = colmap<MODE>(nt * 64 + n4);
            v[q][i] = make_float4(0.f, 0.f, 0.f, 0.f);
            if (sc >= 0) v[q][i] = *(const float4*)(src + (size_t)(kt * 64 + k) * ldsrc + sc);
        }
    }
#pragma unroll
    for (int q = 0; q < 4; ++q) {
        bf16_t* tile = (bf16_t*)smem + q * (64 * 72);
#pragma unroll
        for (int i = 0; i < 2; ++i) {
            const int k = (tid >> 4) + 32 * i, n4 = (tid & 15) * 4;
            tile[(n4 + 0) * 72 + k] = f2bf(v[q][i].x);
            tile[(n4 + 1) * 72 + k] = f2bf(v[q][i].y);
            tile[(n4 + 2) * 72 + k] = f2bf(v[q][i].z);
            tile[(n4 + 3) * 72 + k] = f2bf(v[q][i].w);
        }
    }
    __syncthreads();
#pragma unroll
    for (int q = 0; q < 4; ++q) {
        const int kt = (t0 + q) / ntn, nt = (t0 + q) % ntn;
        const bf16_t* tile = (const bf16_t*)smem + q * (64 * 72);
        const int n = tid >> 3, ch = tid & 7;
        const uint4 w = *(const uint4*)(tile + n * 72 + ch * 8);
        *(uint4*)(dst + (size_t)(nt * 64 + n) * K + kt * 64 + ch * 8) = w;
    }
    __syncthreads();
}

__device__ __forceinline__ void phase0(const Params& P, char* smem) {
    const int bid = blockIdx.x, nb = gridDim.x, tid = threadIdx.x, lane = tid & 63, wave = tid >> 6;
    char* ws = P.ws;
    {
        float* csil = (float*)smem;
        float* red = (float*)(smem + 24576);
        float* modp = (float*)(ws + W_MODP);
        for (int task = bid; task < 384; task += nb) {
            const int jb = task % 48, ks = task / 48, k0 = ks * 128;
            for (int idx = tid; idx < 6144; idx += NTHREADS) {
                const int k = idx / 48, r = idx % 48;
                const float cv = r < 16 ? P.c_prompt[r * 1024 + k0 + k] : P.c_sample[(r - 16) * 1024 + k0 + k];
                csil[k * 48 + r] = siluf_(cv);
            }
            __syncthreads();
            float acc[48];
#pragma unroll
            for (int r = 0; r < 48; ++r) acc[r] = 0.f;
            float wpre[16];
#pragma unroll
            for (int kk = 0; kk < 16; ++kk) wpre[kk] = P.w_mod[(size_t)(k0 + 16 * wave + kk) * 3072 + jb * 64 + lane];
#pragma unroll
            for (int kk = 0; kk < 16; ++kk) {
                const int k = 16 * wave + kk;
                const float wv = wpre[kk];
#pragma unroll
                for (int r4 = 0; r4 < 12; ++r4) {
                    const float4 c4 = *(const float4*)(csil + k * 48 + 4 * r4);
                    acc[4 * r4 + 0] += wv * c4.x; acc[4 * r4 + 1] += wv * c4.y;
                    acc[4 * r4 + 2] += wv * c4.z; acc[4 * r4 + 3] += wv * c4.w;
                }
            }
#pragma unroll
            for (int r = 0; r < 48; ++r) red[(wave * 48 + r) * 64 + lane] = acc[r];
            __syncthreads();
            for (int idx = tid; idx < 3072; idx += NTHREADS) {
                const int r = idx >> 6, col = idx & 63;
                float s = 0.f;
#pragma unroll
                for (int w = 0; w < 8; ++w) s += red[(w * 48 + r) * 64 + col];
                modp[(size_t)(ks * 48 + r) * 3072 + jb * 64 + col] = s;
            }
            __syncthreads();
        }
    }
    {
        const int T_IN = 16 * 80 / 4, T_G = 8 * 16 / 4, T_O = 16 * 16 / 4;
        const int total = T_IN + 3 * T_G + T_O;
        for (int task = bid; task < total; task += nb) {
            int t = task;
            if (t < T_IN) { transpose_tiles4<0>(P.w_in, NIN, 1024, (bf16_t*)(ws + W_WTIN), t * 4, 80, smem); continue; }
            t -= T_IN;
            if (t < T_G) { transpose_tiles4<1>(P.w_glu, 1024, 512, (bf16_t*)(ws + W_WTGLU), t * 4, 16, smem); continue; }
            t -= T_G;
            if (t < T_G) { transpose_tiles4<2>(P.w_ap, 1024, 512, (bf16_t*)(ws + W_WTAP), t * 4, 16, smem); continue; }
            t -= T_G;
            if (t < T_G) { transpose_tiles4<2>(P.w_sp, 1024, 512, (bf16_t*)(ws + W_WTSP), t * 4, 16, smem); continue; }
            t -= T_G;
            transpose_tiles4<2>(P.w_out, 1024, 1024, (bf16_t*)(ws + W_WTOUT), t * 4, 16, smem);
        }
    }
    const int gtid = bid * NTHREADS + tid, gn = nb * NTHREADS;
    {
        float* rt = (float*)(ws + W_ROPE);
        for (int idx = gtid; idx < 2048 * 8; idx += gn) {
            const int pos = idx >> 3, f = idx & 7;
            const float inv = fexp2(-(float)f * 0.125f * 18.931568569324174f);
            float s, c;
            sincos_big((float)pos * inv, s, c);
            rt[pos * 16 + f] = c; rt[pos * 16 + 8 + f] = s;
        }
    }
    {
        bf16_t* Bt = (bf16_t*)(ws + W_BT);
        bf16_t* WE = (bf16_t*)(ws + W_WE);
        float* A1 = (float*)(ws + W_A1);
        float* A32 = (float*)(ws + W_A32);
        for (int idx = gtid; idx < 32 * 64 * 32; idx += gn) {
            const int s = idx & 31, gp = idx >> 5, g = gp >> 6, p = gp & 63;
            const float dt = __expf(P.log_dt[g]);
            const float lr = P.lam_re[gp], li = P.lam_im[gp];
            float sn, cs;
            sincos_big(li * dt, sn, cs);
            const float mag = __expf(lr * dt);
            const float ar = mag * cs, ai = mag * sn;
            const float den = lr * lr + li * li;
            const float zr = ((ar - 1.f) * lr + ai * li) / den;
            const float zi = (ai * lr - (ar - 1.f) * li) / den;
            if (s == 0) {
                A1[gp * 2] = ar; A1[gp * 2 + 1] = ai;
                float s32, c32;
                sincos_big(li * dt * 32.f, s32, c32);
                const float m32 = __expf(lr * dt * 32.f);
                A32[gp * 2] = m32 * c32; A32[gp * 2 + 1] = m32 * s32;
            }
            const float m = (float)(31 - s);
            float sp, cp;
            sincos_big(li * dt * m, sp, cp);
            const float mp = __expf(lr * dt * m);
            const float pr = mp * cp, pi = mp * sp;
#pragma unroll
            for (int c = 0; c < 16; ++c) {
                const float br = P.b_re[(size_t)gp * 16 + c], bi = P.b_im[(size_t)gp * 16 + c];
                const float bbr = zr * br - zi * bi, bbi = zr * bi + zi * br;
                if (s == 0) {
                    Bt[((size_t)g * 128 + p) * 16 + c] = f2bf(bbr);
                    Bt[((size_t)g * 128 + 64 + p) * 16 + c] = f2bf(bbi);
                }
                WE[((size_t)g * 128 + p) * 512 + s * 16 + c] = f2bf(pr * bbr - pi * bbi);
                WE[((size_t)g * 128 + 64 + p) * 512 + s * 16 + c] = f2bf(pr * bbi + pi * bbr);
            }
        }
        bf16_t* Cc = (bf16_t*)(ws + W_CC);
        for (int idx = gtid; idx < 32 * 16 * 128; idx += gn) {
            const int pos = idx & 127, gc = idx >> 7;
            const int pl = pos >> 2, ct = pos & 3;
            const int p = pl + 32 * (ct & 1);
            const float v = (ct >> 1) ? -P.c_im[(size_t)gc * 64 + p] : P.c_re[(size_t)gc * 64 + p];
            Cc[idx] = f2bf(v);
        }
    }
    {
        bf16_t* Ks = (bf16_t*)(ws + W_KS);
        bf16_t* KIs = (bf16_t*)(ws + W_KIS);
        bf16_t* Vts = (bf16_t*)(ws + W_VTS);
        for (int base = gtid; base < 32 * 1024 * 32; base += 8 * gn) {
            float4 v[8];
#pragma unroll
            for (int u = 0; u < 8; ++u) { const int idx = base + u * gn; if (idx < 32 * 1024 * 32) v[u] = *(const float4*)(P.cache_k + (size_t)idx * 4); }
#pragma unroll
            for (int u = 0; u < 8; ++u) {
                const int idx = base + u * gn;
                if (idx < 32 * 1024 * 32) {
                    const int c4 = idx & 31, bl = idx >> 5, b = bl >> 10, l = bl & 1023, c = c4 * 4;
                    st_bf4(Ks + kf_index(b * 2 + (c >> 6), 34, l, c & 63), v[u].x, v[u].y, v[u].z, v[u].w);
                }
            }
        }
        for (int base = gtid; base < 32 * 1024 * 16; base += 4 * gn) {
            float4 v[4];
#pragma unroll
            for (int u = 0; u < 4; ++u) { const int idx = base + u * gn; if (idx < 32 * 1024 * 16) v[u] = *(const float4*)(P.cache_idx_k + (size_t)idx * 4); }
#pragma unroll
            for (int u = 0; u < 4; ++u) {
                const int idx = base + u * gn;
                if (idx < 32 * 1024 * 16) {
                    const int c4 = idx & 15, bl = idx >> 4, b = bl >> 10, l = bl & 1023;
                    st_bf4(KIs + kf_index(b, 34, l, c4 * 4), v[u].x, v[u].y, v[u].z, v[u].w);
                }
            }
        }
        for (int base = gtid; base < 32 * 256 * 128; base += 4 * gn) {
            float v[4][4];
#pragma unroll
            for (int u = 0; u < 4; ++u) {
                const int idx = base + u * gn;
                if (idx < 32 * 256 * 128) {
                    const int gd = idx & 127, rest = idx >> 7, l4 = rest & 255, b = rest >> 8;
                    const float* src = P.cache_v + ((size_t)b * 1024 + l4 * 4) * 128 + gd;
                    v[u][0] = src[0]; v[u][1] = src[128]; v[u][2] = src[256]; v[u][3] = src[384];
                }
            }
#pragma unroll
            for (int u = 0; u < 4; ++u) {
                const int idx = base + u * gn;
                if (idx < 32 * 256 * 128) {
                    const int gd = idx & 127, rest = idx >> 7, l4 = rest & 255, b = rest >> 8;
                    st_bf4(Vts + vf_index(b * 2 + (gd >> 6), 34, l4 * 4, gd & 63), v[u][0], v[u][1], v[u][2], v[u][3]);
                }
            }
        }
    }
}

__device__ __forceinline__ void phase1(const Params& P, char* smem) {
    const int bid = blockIdx.x, nb = gridDim.x, tid = threadIdx.x, lane = tid & 63, wave = tid >> 6;
    char* ws = P.ws;
    const float* modp = (const float*)(ws + W_MODP);
    {
        float* modf = (float*)(ws + W_MODF);
        for (int idx = bid * NTHREADS + tid; idx < 48 * 3072; idx += nb * NTHREADS) {
            float s = P.b_mod[idx % 3072];
#pragma unroll
            for (int k = 0; k < 8; ++k) s += modp[(size_t)k * 48 * 3072 + idx];
            modf[idx] = s;
        }
    }
    float* gsc = (float*)smem;
    float* shf = gsc + 1024;
    bf16_t* H = (bf16_t*)(ws + W_H);
    for (int task = bid; task < NTOK / 64; task += nb) {
        const int tok0 = task * 64, r = modrow(tok0);
        for (int k = tid; k < 1024; k += NTHREADS) {
            float sh = P.b_mod[k], sc = P.b_mod[1024 + k];
#pragma unroll
            for (int s = 0; s < 8; ++s) {
                sh += modp[(size_t)(s * 48 + r) * 3072 + k];
                sc += modp[(size_t)(s * 48 + r) * 3072 + 1024 + k];
            }
            gsc[k] = P.g_norm[k] * (1.f + sc);
            shf[k] = sh;
        }
        __syncthreads();
        for (int rb = 0; rb < 2; ++rb) {
            float4 v[4][4];
#pragma unroll
            for (int r4 = 0; r4 < 4; ++r4) {
                const float* x = xrow(P, tok0 + wave * 8 + rb * 4 + r4);
#pragma unroll
                for (int i = 0; i < 4; ++i) v[r4][i] = *(const float4*)(x + 4 * lane + 256 * i);
            }
#pragma unroll
            for (int r4 = 0; r4 < 4; ++r4) {
                const int tok = tok0 + wave * 8 + rb * 4 + r4;
                float ss = 0.f;
#pragma unroll
                for (int i = 0; i < 4; ++i) ss += v[r4][i].x * v[r4][i].x + v[r4][i].y * v[r4][i].y + v[r4][i].z * v[r4][i].z + v[r4][i].w * v[r4][i].w;
#pragma unroll
                for (int o = 32; o >= 1; o >>= 1) ss += __shfl_xor(ss, o);
                const float rinv = rsqrtf(ss * (1.f / 1024.f) + 1e-6f);
#pragma unroll
                for (int i = 0; i < 4; ++i) {
                    const int k = 4 * lane + 256 * i;
                    const float4 g4 = *(const float4*)(gsc + k), s4 = *(const float4*)(shf + k);
                    st_bf4(H + (size_t)tok * 1024 + k, v[r4][i].x * rinv * g4.x + s4.x, v[r4][i].y * rinv * g4.y + s4.y,
                           v[r4][i].z * rinv * g4.z + s4.z, v[r4][i].w * rinv * g4.w + s4.w);
                }
            }
        }
        __syncthreads();
    }
}

namespace pg8 {
#define PG8_LAS __attribute__((address_space(3)))
constexpr int BM = 256, BK = 64, HALF = 128, HTB = HALF * BK * 2, STAGE_BYTES = 8 * HTB, NXCD = 8, WGM = 8;
__device__ __forceinline__ int lds_byte(int r, int c) { const int st = (r >> 4) * 2 + (c >> 5), rr = r & 15, cc = c & 31, ob = rr * 64 + cc * 2; return st * 1024 + (ob ^ (((ob >> 9) & 1) << 5)); }
__device__ __forceinline__ void stage_rc(int b, int& R, int& C) { const int st = b / 1024, sb = b % 1024, swz = sb ^ (((sb >> 9) & 1) << 5); R = (st >> 1) * 16 + swz / 64; C = (st & 1) * 32 + (swz % 64) / 2; }
__device__ __forceinline__ int perm32(int rho) { const int n = rho >> 4, i = rho & 15; return 8 * (i >> 2) + 4 * n + (i & 3); }
struct Unit { int pm, pn; };
struct Gemm { const bf16_t* A; const bf16_t* Bt; int M, N, K; };
struct StaticOrder {
    int nM, nN, nwg, G, c;
    __device__ void init(int M, int N, int G_, int c_) { nM = M / BM; nN = N / BM; nwg = nM * nN; G = G_; c = c_; }
    __device__ bool next(int i, Unit& u) const {
        const long L = (long)i * G + c; if (L >= nwg) return false;
        int wgid = (int)L; { const int q = nwg / NXCD, r = nwg % NXCD, xcd = wgid % NXCD, off = wgid / NXCD; wgid = (xcd < r ? xcd * (q + 1) : r * (q + 1) + (xcd - r) * q) + off; }
        const int nig = WGM * nN, gid = wgid / nig, fm = gid * WGM, gsz = (nM - fm) < WGM ? (nM - fm) : WGM;
        u.pm = fm + ((wgid % nig) % gsz); u.pn = (wgid % nig) / gsz; return true;
    }
};
template <class Epi>
__device__ __forceinline__ void gemm_phase(PG8_LAS unsigned char* lds, const Gemm g, const StaticOrder& S, const Epi& E) {
    int tid = threadIdx.x;
    asm volatile("" : "+v"(tid));
    const int wid = __builtin_amdgcn_readfirstlane(tid >> 6), lane = tid & 63, wr = wid >> 2, wc = wid & 3, fr = lane & 15, fq = lane >> 4;
    const int K = g.K, nt = K / BK;
    unsigned voffA[2], voffB[2];
#pragma unroll
    for (int i = 0; i < 2; ++i) { int R, C; stage_rc(tid * 16 + i * 8192, R, C); const int Rb = (R & ~31) + perm32(R & 31);
        voffA[i] = (unsigned)(R * K + C) * 2u; voffB[i] = (unsigned)(Rb * K + C) * 2u; }
    const size_t kstep = (size_t)(BK * 2);
    const size_t hstep = (size_t)HALF * K * 2;
    const size_t tstep = 2 * hstep;
    const unsigned ldsw = (unsigned)wid * 1024u;
    const int aoff = lds_byte(wr * 64 + fr, fq * 8), boff = lds_byte(wc * 32 + fr, fq * 8);
#define PG8_SA(b, h) (((b) * 2 + (h)) * HTB)
#define PG8_SB(b, h) ((4 + (b) * 2 + (h)) * HTB)
#define PG8_STAGE(bufoff, gbase, voff) do { _Pragma("unroll") for (int _i = 0; _i < 2; ++_i) \
        __builtin_amdgcn_global_load_lds((const unsigned*)((const char*)(gbase) + (voff)[_i]), (PG8_LAS unsigned*)(lds + (bufoff) + ldsw + _i * 8192), 16, 0, 0); } while (0)
#define PG8_LDA(dst, b, h) do { _Pragma("unroll") for (int m = 0; m < 4; ++m) _Pragma("unroll") for (int k = 0; k < 2; ++k) dst[m][k] = *(const PG8_LAS bf16x8*)(lds + PG8_SA(b, h) + aoff + m * 2048 + k * 1024); } while (0)
#define PG8_LDB(dst, b, h) do { _Pragma("unroll") for (int n = 0; n < 2; ++n) _Pragma("unroll") for (int k = 0; k < 2; ++k) dst[n][k] = *(const PG8_LAS bf16x8*)(lds + PG8_SB(b, h) + boff + n * 2048 + k * 1024); } while (0)
#define PG8_MMA(ai, bj, At, Bt) do { __builtin_amdgcn_s_setprio(1); _Pragma("unroll") for (int m = 0; m < 4; ++m) _Pragma("unroll") for (int n = 0; n < 2; ++n) _Pragma("unroll") for (int k = 0; k < 2; ++k) \
        acc[ai][bj][m][n] = __builtin_amdgcn_mfma_f32_16x16x32_bf16(Bt[n][k], At[m][k], acc[ai][bj][m][n], 0, 0, 0); __builtin_amdgcn_s_setprio(0); } while (0)
#define PG8_WAIT_V(n) asm volatile("s_waitcnt vmcnt(" #n ")" ::: "memory")
#define PG8_WAIT_L(n) asm volatile("s_waitcnt lgkmcnt(" #n ")" ::: "memory")
#define PG8_BAR __builtin_amdgcn_s_barrier()
#define PG8_SCHED __builtin_amdgcn_sched_barrier(0)
    Unit cur, nxt; int ui = 0;
    if (!S.next(0, cur)) return;
    f32x4 acc[2][2][4][2];
#pragma unroll
    for (int a = 0; a < 2; ++a)
#pragma unroll
        for (int b = 0; b < 2; ++b)
#pragma unroll
            for (int m = 0; m < 4; ++m)
#pragma unroll
                for (int n = 0; n < 2; ++n) acc[a][b][m][n] = (f32x4){0.f, 0.f, 0.f, 0.f};
    bf16x8 At[4][2], B0[2][2], B1[2][2];
    const char* cA = (const char*)g.A + (size_t)cur.pm * tstep; const char* cB = (const char*)g.Bt + (size_t)cur.pn * tstep;
    PG8_STAGE(PG8_SB(0, 0), cB, voffB); PG8_STAGE(PG8_SA(0, 0), cA, voffA); PG8_STAGE(PG8_SB(0, 1), cB + hstep, voffB); PG8_STAGE(PG8_SA(0, 1), cA + hstep, voffA);
    if (wr == 1) PG8_BAR;
    PG8_WAIT_V(4); PG8_BAR;
    PG8_STAGE(PG8_SB(1, 0), cB + kstep, voffB); PG8_STAGE(PG8_SA(1, 0), cA + kstep, voffA); PG8_STAGE(PG8_SB(1, 1), cB + hstep + kstep, voffB);
    PG8_WAIT_V(6); PG8_BAR;
    for (;;) {
        const bool has_next = S.next(ui + 1, nxt);
        const char* nA = has_next ? (const char*)g.A + (size_t)nxt.pm * tstep : cA; const char* nB = has_next ? (const char*)g.Bt + (size_t)nxt.pn * tstep : cB;
        for (int t = 0; t < nt; t += 2) {
            const bool last = (t == nt - 2);
            const char* a1 = cA + (size_t)(t + 1) * kstep;
            const char* a2 = last ? nA : cA + (size_t)(t + 2) * kstep; const char* b2 = last ? nB : cB + (size_t)(t + 2) * kstep;
            const char* a3 = a2 + kstep; const char* b3 = b2 + kstep;
            PG8_LDB(B0, 0, 0); PG8_SCHED; PG8_LDA(At, 0, 0); PG8_STAGE(PG8_SA(1, 1), a1 + hstep, voffA);
            PG8_WAIT_L(8); PG8_BAR; PG8_WAIT_L(0); PG8_MMA(0, 0, At, B0); PG8_BAR; PG8_SCHED;
            PG8_LDB(B1, 0, 1); PG8_STAGE(PG8_SB(0, 0), b2, voffB);
            PG8_BAR; PG8_WAIT_L(0); PG8_MMA(0, 1, At, B1); PG8_BAR;
            PG8_LDA(At, 0, 1); PG8_STAGE(PG8_SA(0, 0), a2, voffA);
            PG8_BAR; PG8_WAIT_L(0); PG8_MMA(1, 0, At, B0); PG8_BAR; PG8_SCHED;
            PG8_STAGE(PG8_SB(0, 1), b2 + hstep, voffB);
            PG8_WAIT_V(6); PG8_BAR; PG8_MMA(1, 1, At, B1); PG8_BAR;
            PG8_LDB(B0, 1, 0); PG8_SCHED; PG8_LDA(At, 1, 0); PG8_STAGE(PG8_SA(0, 1), a2 + hstep, voffA);
            PG8_WAIT_L(8); PG8_BAR; PG8_WAIT_L(0); PG8_MMA(0, 0, At, B0); PG8_BAR; PG8_SCHED;
            PG8_LDB(B1, 1, 1); PG8_STAGE(PG8_SB(1, 0), b3, voffB);
            PG8_BAR; PG8_WAIT_L(0); PG8_MMA(0, 1, At, B1); PG8_BAR;
            PG8_LDA(At, 1, 1); PG8_STAGE(PG8_SA(1, 0), a3, voffA);
            PG8_BAR; PG8_WAIT_L(0); PG8_MMA(1, 0, At, B0); PG8_BAR; PG8_SCHED;
            PG8_STAGE(PG8_SB(1, 1), b3 + hstep, voffB);
            PG8_WAIT_V(6); PG8_BAR; PG8_MMA(1, 1, At, B1); PG8_BAR;
        }
        E(acc, cur, wr, wc, fr, fq);
        if (!has_next) break;
#pragma unroll
        for (int a = 0; a < 2; ++a)
#pragma unroll
            for (int b = 0; b < 2; ++b)
#pragma unroll
                for (int m = 0; m < 4; ++m)
#pragma unroll
                    for (int n = 0; n < 2; ++n) acc[a][b][m][n] = (f32x4){0.f, 0.f, 0.f, 0.f};
        cur = nxt; cA = nA; cB = nB; ++ui;
    }
    PG8_WAIT_V(0);
    if (wr == 0) PG8_BAR;
    PG8_BAR;
#undef PG8_SA
#undef PG8_SB
#undef PG8_STAGE
#undef PG8_LDA
#undef PG8_LDB
#undef PG8_MMA
#undef PG8_WAIT_V
#undef PG8_WAIT_L
#undef PG8_BAR
#undef PG8_SCHED
}
}

__device__ __forceinline__ void st_bf8(bf16_t* p, const f32x4& a, const f32x4& b) {
    uint4 v; v.x = pack2(a[0], a[1]); v.y = pack2(a[2], a[3]); v.z = pack2(b[0], b[1]); v.w = pack2(b[2], b[3]);
    *(uint4*)p = v;
}
template <int ACT> __device__ __forceinline__ f32x4 act4(f32x4 v) {
    if (ACT == 1) { v[0] = siluf_(v[0]); v[1] = siluf_(v[1]); v[2] = siluf_(v[2]); v[3] = siluf_(v[3]); }
    if (ACT == 2) { v[0] = sigmoidf_(v[0]); v[1] = sigmoidf_(v[1]); v[2] = sigmoidf_(v[2]); v[3] = sigmoidf_(v[3]); }
    return v;
}

struct EpiIn {
    Params P;
    __device__ __forceinline__ void operator()(const f32x4 (&acc)[2][2][4][2], const pg8::Unit& u, int wr, int wc, int fr, int fq) const {
        char* ws = P.ws;
        const float* rt = (const float*)(ws + W_ROPE);
#pragma unroll
        for (int bj = 0; bj < 2; ++bj) {
            const int c32 = u.pn * 256 + bj * 128 + wc * 32;
            if (c32 >= NINP || c32 == 1376) continue;
            const int cl = 8 * fq;
#pragma unroll
            for (int ai = 0; ai < 2; ++ai)
#pragma unroll
                for (int m = 0; m < 4; ++m) {
                    const int tok = u.pm * 256 + ai * 128 + wr * 64 + m * 16 + fr;
                    const bool smp = tok >= NP;
                    const int st = tok - NP;
                    const int b = smp ? (st >> 6) : (tok >> 11);
                    const int t = smp ? (st & 63) : (tok & 2047);
                    const int pos = smp ? 1024 + t : t;
                    f32x4 v0 = acc[ai][bj][m][0], v1 = acc[ai][bj][m][1];
                    const bool ropeable = (c32 < 640) || (c32 >= 768 && c32 < 1344);
                    if (ropeable && (c32 & 63) == 0) {
                        f32x4 p0, p1;
#pragma unroll
                        for (int j = 0; j < 4; ++j) { p0[j] = __shfl_xor(v0[j], 16); p1[j] = __shfl_xor(v1[j], 16); }
                        if (fq < 2) {
                            const f32x4 c0 = *(const f32x4*)(rt + pos * 16), c1 = *(const f32x4*)(rt + pos * 16 + 4);
                            const f32x4 s0 = *(const f32x4*)(rt + pos * 16 + 8), s1 = *(const f32x4*)(rt + pos * 16 + 12);
                            const float sg = fq == 0 ? -1.f : 1.f;
#pragma unroll
                            for (int j = 0; j < 4; ++j) { v0[j] = v0[j] * c0[j] + sg * p0[j] * s0[j]; v1[j] = v1[j] * c1[j] + sg * p1[j] * s1[j]; }
                        }
                    }
                    if (c32 < 512) {
                        st_bf8((bf16_t*)(ws + W_Q) + (size_t)tok * 512 + c32 + cl, v0, v1);
                    } else if (c32 < 640) {
                        const int c = c32 - 512 + cl;
                        st_bf8((bf16_t*)(ws + (smp ? W_KS : W_KP)) + kf_index(b * 2 + (c >> 6), smp ? 34 : 64, pos, c & 63), v0, v1);
                        float* o = P.out + (smp ? O_KS + (size_t)st * 128 : O_KP + (size_t)tok * 128) + c;
                        *(f32x4*)o = v0; *(f32x4*)(o + 4) = v1;
                    } else if (c32 < 768) {
                        const int c = c32 - 640 + cl;
                        float* o = P.out + (smp ? O_VS + (size_t)st * 128 : O_VP + (size_t)tok * 128) + c;
                        *(f32x4*)o = v0; *(f32x4*)(o + 4) = v1;
                        bf16_t* vt = (bf16_t*)(ws + (smp ? W_VTS : W_VTP)) + vf_index(b * 2 + (c >> 6), smp ? 34 : 64, pos, c & 63);
#pragma unroll
                        for (int e = 0; e < 4; ++e) {
                            vt[e * 8] = f2bf(v0[e]);
                            vt[(4 + e) * 8] = f2bf(v1[e]);
                        }
                    } else if (c32 < 1280) {
                        st_bf8((bf16_t*)(ws + W_QI) + (size_t)tok * 512 + (c32 - 768) + cl, v0, v1);
                    } else if (c32 < 1344) {
                        const int c = c32 - 1280 + cl;
                        st_bf8((bf16_t*)(ws + (smp ? W_KIS : W_KIP)) + kf_index(b, smp ? 34 : 64, pos, c), v0, v1);
                        float* o = P.out + (smp ? O_KIS + (size_t)st * 64 : O_KIP + (size_t)tok * 64) + c;
                        *(f32x4*)o = v0; *(f32x4*)(o + 4) = v1;
                    } else if (c32 < 1376) {
                        if (fq == 0) {
                            const float sc = 0.35355339059327373f;
                            float* o = (float*)(ws + W_WI) + (size_t)tok * 8;
                            *(f32x4*)o = v0 * sc; *(f32x4*)(o + 4) = v1 * sc;
                        }
                    } else if (c32 < 1920) {
                        st_bf8((bf16_t*)(ws + W_GA) + (size_t)tok * 512 + (c32 - 1408) + cl, act4<1>(v0), act4<1>(v1));
                    } else if (c32 < 2432) {
                        st_bf8((bf16_t*)(ws + W_U) + (size_t)tok * 512 + (c32 - 1920) + cl, v0, v1);
                    } else if (c32 < 2944) {
                        st_bf8((bf16_t*)(ws + W_GS) + (size_t)tok * 512 + (c32 - 2432) + cl, act4<1>(v0), act4<1>(v1));
                    } else if (c32 < 3968) {
                        st_bf8((bf16_t*)(ws + W_MA) + (size_t)tok * 1024 + (c32 - 2944) + cl, act4<2>(v0), act4<2>(v1));
                    } else {
                        st_bf8((bf16_t*)(ws + W_MB) + (size_t)tok * 1024 + (c32 - 3968) + cl, act4<2>(v0), act4<2>(v1));
                    }
                }
        }
    }
};
__device__ __forceinline__ void phase2(const Params& P, char* smem) {
    pg8::StaticOrder S; S.init(NTOK, NINP2, (int)gridDim.x, (int)blockIdx.x);
    pg8::Gemm g{(const bf16_t*)(P.ws + W_H), (const bf16_t*)(P.ws + W_WTIN), NTOK, NINP2, 1024};
    EpiIn E{P};
    pg8::gemm_phase(( PG8_LAS unsigned char*)smem, g, S, E);
}

__device__ __forceinline__ void phase3(const Params& P, char* smem) {
    const int tid = threadIdx.x, lane = tid & 63, wave = tid >> 6, l32 = lane & 31, hh = lane >> 5;
    char* ws = P.ws;
    const bf16_t* U = (const bf16_t*)(ws + W_U);
    const bf16_t* WE = (const bf16_t*)(ws + W_WE);
    const float* A32 = (const float*)(ws + W_A32);
    float* HIN = (float*)(ws + W_E);
    for (int task = blockIdx.x * 8 + wave; task < 1024 + 64; task += gridDim.x * 8) {
        if (task < 1024) {
            const int sp = task & 1, g = (task >> 1) & 31, b = task >> 6;
            f32x16 acc[2][2];
#pragma unroll
            for (int rt = 0; rt < 2; ++rt)
#pragma unroll
                for (int c2 = 0; c2 < 2; ++c2)
#pragma unroll
                    for (int e = 0; e < 16; ++e) acc[rt][c2][e] = 0.f;
            const int sc0 = 32 * ((l32 >> 2) & 1) + 4 * (l32 >> 3) + (l32 & 3);
            const bf16_t* up0 = U + ((size_t)b * 2048 + (size_t)sc0 * 32) * 512 + g * 16 + 8 * hh;
            const bf16_t* up1 = up0 + (size_t)16 * 32 * 512;
            const bf16_t* wp = WE + ((size_t)g * 128 + sp * 32 + l32) * 512 + 8 * hh;
#pragma unroll 8
            for (int ks = 0; ks < 32; ++ks) {
                const bf16x8 a0 = *(const bf16x8*)(up0 + (size_t)ks * 512);
                const bf16x8 a1 = *(const bf16x8*)(up1 + (size_t)ks * 512);
#pragma unroll
                for (int c2 = 0; c2 < 2; ++c2) {
                    const bf16x8 bfr = *(const bf16x8*)(wp + (size_t)c2 * 64 * 512 + ks * 16);
                    acc[0][c2] = MFMA32(a0, bfr, acc[0][c2]);
                    acc[1][c2] = MFMA32(a1, bfr, acc[1][c2]);
                }
            }
            const int p = 32 * sp + l32, gp = g * 64 + p;
            const float a32r = A32[gp * 2], a32i = A32[gp * 2 + 1];
            float sr = 0.f, si = 0.f;
#pragma unroll
            for (int pass = 0; pass < 2; ++pass) {
                float hr = sr, hi = si;
#pragma unroll
                for (int rt = 0; rt < 2; ++rt)
#pragma unroll
                    for (int e = 0; e < 16; ++e) {
                        if (hh == pass) {
                            float* o = HIN + (((size_t)b * 64 + 32 * hh + 16 * rt + e) * 32 + g) * 128 + p;
                            o[0] = hr; o[64] = hi;
                        }
                        const float nr = a32r * hr - a32i * hi + acc[rt][0][e];
                        const float ni = a32r * hi + a32i * hr + acc[rt][1][e];
                        hr = nr; hi = ni;
                    }
                if (pass == 0) { sr = __shfl(hr, l32); si = __shfl(hi, l32); }
            }
        } else {
            const int sp = (task - 1024) & 1, g = (task - 1024) >> 1;
            f32x16 acc[2];
#pragma unroll
            for (int c2 = 0; c2 < 2; ++c2)
#pragma unroll
                for (int e = 0; e < 16; ++e) acc[c2][e] = 0.f;
            const bf16_t* up = U + ((size_t)NP + (size_t)l32 * 64) * 512 + g * 16 + 8 * hh;
            const bf16_t* wp = WE + ((size_t)g * 128 + sp * 32 + l32) * 512 + 8 * hh;
#pragma unroll 8
            for (int ks = 0; ks < 32; ++ks) {
                const bf16x8 a = *(const bf16x8*)(up + (size_t)ks * 512);
#pragma unroll
                for (int c2 = 0; c2 < 2; ++c2) {
                    const bf16x8 bfr = *(const bf16x8*)(wp + (size_t)c2 * 64 * 512 + ks * 16);
                    acc[c2] = MFMA32(a, bfr, acc[c2]);
                }
            }
            const int p = 32 * sp + l32, gp = g * 64 + p;
            const float a32r = A32[gp * 2], a32i = A32[gp * 2 + 1];
#pragma unroll
            for (int e = 0; e < 16; ++e) {
                const int bb = 8 * (e >> 2) + 4 * hh + (e & 3);
                const float h0r = P.st_re[(size_t)(bb * 32 + g) * 64 + p], h0i = P.st_im[(size_t)(bb * 32 + g) * 64 + p];
                float* o = HIN + (((size_t)1024 + bb) * 32 + g) * 128 + p;
                o[0] = a32r * h0r - a32i * h0i + acc[0][e];
                o[64] = a32r * h0i + a32i * h0r + acc[1][e];
            }
        }
    }
}

__device__ __forceinline__ void attn_task(const Params& P, int task, char* smem, bool dummy_out = false) {
    const int tid = threadIdx.x, lane = tid & 63, wave = tid >> 6, l32 = lane & 31, hh = lane >> 5;
    char* ws = P.ws;
    int tok0, L, n_adm;
    const bf16_t *KIb, *Kb, *Vtb;
    if (task < 2048) {
        const int qt = 127 - (task >> 4), b = task & 15;
        tok0 = b * 2048 + qt * 16; L = 2048; n_adm = ((qt >> 2) + 1) * 64;
        KIb = (const bf16_t*)(ws + W_KIP) + (size_t)b * 2048 * 64;
        Kb = (const bf16_t*)(ws + W_KP) + (size_t)b * 2048 * 128;
        Vtb = (const bf16_t*)(ws + W_VTP) + (size_t)b * 128 * 2048;
    } else {
        const int s = task - 2048, b = s >> 2, qt = s & 3;
        tok0 = NP + b * 64 + qt * 16; L = 1088; n_adm = 1088;
        KIb = (const bf16_t*)(ws + W_KIS) + (size_t)b * 1088 * 64;
        Kb = (const bf16_t*)(ws + W_KS) + (size_t)b * 1088 * 128;
        Vtb = (const bf16_t*)(ws + W_VTS) + (size_t)b * 128 * 1088;
    }
    const int ntile = n_adm >> 5;
    float* sc = (float*)smem;
    bf16x8 bq[4];
    {
        const bf16_t* Q = (const bf16_t*)(ws + W_Q);
        const int g3 = wave >> 2, qh3 = (wave >> 1) & 1;
        const int q3 = qh3 * 8 + (l32 >> 2), head3 = g3 * 4 + (l32 & 3);
#pragma unroll
        for (int ks = 0; ks < 4; ++ks) bq[ks] = *(const bf16x8*)(Q + (size_t)(tok0 + q3) * 512 + head3 * 64 + 32 * hh + 8 * ks);
    }
    {
        const bf16_t* QI = (const bf16_t*)(ws + W_QI);
        const float* WI = (const float*)(ws + W_WI);
        const int rg = wave >> 2, kq = wave & 3;
        bf16x8 aq[2][4];
        float wreg[2][16];
#pragma unroll
        for (int rt = 0; rt < 2; ++rt) {
            const int i = l32 >> 3, hR = (l32 >> 2) & 1, j = l32 & 3;
            const int q = rg * 8 + rt * 4 + 2 * hR + (i >> 1), head = 4 * (i & 1) + j;
#pragma unroll
            for (int ks = 0; ks < 4; ++ks) aq[rt][ks] = *(const bf16x8*)(QI + (size_t)(tok0 + q) * 512 + head * 64 + 32 * hh + 8 * ks);
#pragma unroll
            for (int qq = 0; qq < 2; ++qq) {
                const float* wp = WI + (size_t)(tok0 + rg * 8 + rt * 4 + 2 * hh + qq) * 8;
                const f32x4 w0 = *(const f32x4*)wp, w1 = *(const f32x4*)(wp + 4);
#pragma unroll
                for (int j = 0; j < 4; ++j) { wreg[rt][8 * qq + j] = w0[j] * 0.125f; wreg[rt][8 * qq + 4 + j] = w1[j] * 0.125f; }
            }
        }
        bf16x8 nb[4];
        if (kq < ntile) {
#pragma unroll
            for (int ks = 0; ks < 4; ++ks) nb[ks] = *(const bf16x8*)(KIb + ((size_t)(kq * 4 + ks) * 64 + lane) * 8);
        }
        for (int kt = kq; kt < ntile; kt += 4) {
            const int key = kt * 32 + l32;
            bf16x8 bk[4];
#pragma unroll
            for (int ks = 0; ks < 4; ++ks) bk[ks] = nb[ks];
            if (kt + 4 < ntile) {
#pragma unroll
                for (int ks = 0; ks < 4; ++ks) nb[ks] = *(const bf16x8*)(KIb + ((size_t)((kt + 4) * 4 + ks) * 64 + lane) * 8);
            }
#pragma unroll
            for (int rt = 0; rt < 2; ++rt) {
                f32x16 s;
#pragma unroll
                for (int e = 0; e < 16; ++e) s[e] = 0.f;
#pragma unroll
                for (int ks = 0; ks < 4; ++ks) s = MFMA32(aq[rt][ks], bk[ks], s);
                float s0 = 0.f, s1 = 0.f;
#pragma unroll
                for (int e = 0; e < 8; ++e) {
                    s0 += wreg[rt][e] * fmaxf(s[e], 0.f);
                    s1 += wreg[rt][8 + e] * fmaxf(s[8 + e], 0.f);
                }
                const int q0 = rg * 8 + rt * 4 + 2 * hh;
                sc[q0 * SCLD + key] = s0;
                sc[(q0 + 1) * SCLD + key] = s1;
            }
        }
    }
    __syncthreads();
    {
        const int nv = n_adm >> 6;
        const int qa = wave * 2;
        float v[2][32];
#pragma unroll
        for (int i = 0; i < 32; ++i) {
            v[0][i] = (i < nv) ? sc[qa * SCLD + lane + 64 * i] : -3.0e38f;
            v[1][i] = (i < nv) ? sc[(qa + 1) * SCLD + lane + 64 * i] : -3.0e38f;
        }
        float thr[2] = {-3.0e38f, -3.0e38f};
        if (n_adm > 256) {
#define COUNT_GE(Q, T, OUT) do { int _c = 0; _Pragma("unroll") for (int i = 0; i < 32; ++i) _c += (v[Q][i] >= (T)) ? 1 : 0; \
        int _t = 0; _Pragma("unroll") for (int bb = 0; bb < 6; ++bb) _t += __popcll(__ballot((_c >> bb) & 1)) << bb; (OUT) = _t; } while (0)
            float lo[2], hi[2], mid[2], tprev[2], dens[2];
            int clo[2], chi[2], cprev[2];
            bool done[2];
            const float fn = (float)n_adm;
            const float pq = 256.f / fn;
            const float pt = pq <= 0.5f ? pq : 1.f - pq;
            const float tt = sqrtf(-2.f * __logf(pt));
            float z = tt - (2.30753f + 0.27061f * tt) / (1.f + 0.99229f * tt + 0.04481f * tt * tt);
            if (pq > 0.5f) z = -z;
            const float dz = fn * __expf(-0.5f * z * z) * 0.39894228f;
#pragma unroll
            for (int qq = 0; qq < 2; ++qq) {
                float mx = -3.0e38f, mn = 3.0e38f, s1 = 0.f, s2 = 0.f;
#pragma unroll
                for (int i = 0; i < 32; ++i) {
                    const bool ok = v[qq][i] > -1.0e38f;
                    const float x = ok ? v[qq][i] : 0.f;
                    mx = fmaxf(mx, v[qq][i]); mn = fminf(mn, ok ? v[qq][i] : 3.0e38f);
                    s1 += x; s2 += x * x;
                }
#pragma unroll
                for (int o = 32; o >= 1; o >>= 1) {
                    mx = fmaxf(mx, __shfl_xor(mx, o)); mn = fminf(mn, __shfl_xor(mn, o));
                    s1 += __shfl_xor(s1, o); s2 += __shfl_xor(s2, o);
                }
                int c;
                COUNT_GE(qq, mx, c);
                const float mean = s1 * frcp(fn);
                const float sd = sqrtf(fmaxf(s2 * frcp(fn) - mean * mean, 1e-20f));
                lo[qq] = mn; hi[qq] = mx; clo[qq] = n_adm; chi[qq] = c;
                mid[qq] = mean + z * sd; tprev[qq] = 0.f; cprev[qq] = 256;
                dens[qq] = dz * frcp(sd);
                done[qq] = (c >= 256);
                thr[qq] = done[qq] ? mx : mn;
            }
            for (int it = 0; it < 64 && !(done[0] && done[1]); ++it) {
#pragma unroll
                for (int qq = 0; qq < 2; ++qq) {
                    const float interp = lo[qq] + (hi[qq] - lo[qq]) * ((float)(clo[qq] - 256) * frcp((float)(clo[qq] - chi[qq])));
                    const float bis = 0.5f * (lo[qq] + hi[qq]);
                    float md = mid[qq];
                    if (it == 1) { md = tprev[qq] + (float)(cprev[qq] - 256) * frcp(dens[qq]); if (!(md > lo[qq] && md < hi[qq])) md = interp; }
                    else if (it >= 2) md = (it % 3 != 0) ? interp : bis;
                    if (!(md > lo[qq] && md < hi[qq])) md = bis;
                    mid[qq] = md;
                }
                int cc0 = 0, cc1 = 0;
                COUNT_GE(0, mid[0], cc0);
                COUNT_GE(1, mid[1], cc1);
#pragma unroll
                for (int qq = 0; qq < 2; ++qq) {
                    const int cc = qq ? cc1 : cc0;
                    if (!done[qq]) {
                        const float md = mid[qq];
                        if (!(md > lo[qq] && md < hi[qq])) { thr[qq] = lo[qq]; done[qq] = true; }
                        else if (cc == 256) { thr[qq] = md; done[qq] = true; }
                        else {
                            tprev[qq] = md; cprev[qq] = cc;
                            if (cc > 256) { lo[qq] = md; clo[qq] = cc; } else { hi[qq] = md; chi[qq] = cc; }
                            thr[qq] = lo[qq];
                        }
                    }
                }
            }
#undef COUNT_GE
        }
#pragma unroll
        for (int i = 0; i < 32; ++i)
            if (i < nv) {
                sc[qa * SCLD + lane + 64 * i] = (v[0][i] >= thr[0]) ? 0.f : -1.0e30f;
                sc[(qa + 1) * SCLD + lane + 64 * i] = (v[1][i] >= thr[1]) ? 0.f : -1.0e30f;
            }
    }
    __syncthreads();
    {
        const int g = wave >> 2, qh = (wave >> 1) & 1, ksp = wave & 1;
        const int q = qh * 8 + (l32 >> 2), head = g * 4 + (l32 & 3);
        f32x16 o[2];
#pragma unroll
        for (int e = 0; e < 16; ++e) { o[0][e] = 0.f; o[1][e] = 0.f; }
        float m = -3.0e38f, lsum = 0.f;
        const float c1 = 0.125f * 1.44269504f;
        const bf16_t* Kg = Kb + (size_t)g * L * 64;
        const bf16_t* Vg = Vtb + (size_t)g * L * 64;
        bf16x8 nk[4], nv[2][2];
        if (ksp < ntile) {
#pragma unroll
            for (int ks = 0; ks < 4; ++ks) nk[ks] = *(const bf16x8*)(Kg + ((size_t)(ksp * 4 + ks) * 64 + lane) * 8);
#pragma unroll
            for (int s2 = 0; s2 < 2; ++s2)
#pragma unroll
                for (int dt = 0; dt < 2; ++dt) nv[dt][s2] = *(const bf16x8*)(Vg + ((size_t)((ksp * 2 + s2) * 2 + dt) * 64 + lane) * 8);
        }
        for (int kt = ksp; kt < ntile; kt += 2) {
            bf16x8 ak[4], av[2][2];
#pragma unroll
            for (int ks = 0; ks < 4; ++ks) ak[ks] = nk[ks];
#pragma unroll
            for (int s2 = 0; s2 < 2; ++s2)
#pragma unroll
                for (int dt = 0; dt < 2; ++dt) av[dt][s2] = nv[dt][s2];
            if (kt + 2 < ntile) {
                const int kn = kt + 2;
#pragma unroll
                for (int ks = 0; ks < 4; ++ks) nk[ks] = *(const bf16x8*)(Kg + ((size_t)(kn * 4 + ks) * 64 + lane) * 8);
#pragma unroll
                for (int s2 = 0; s2 < 2; ++s2)
#pragma unroll
                    for (int dt = 0; dt < 2; ++dt) nv[dt][s2] = *(const bf16x8*)(Vg + ((size_t)((kn * 2 + s2) * 2 + dt) * 64 + lane) * 8);
            }
            f32x16 s;
#pragma unroll
            for (int e = 0; e < 16; ++e) s[e] = 0.f;
#pragma unroll
            for (int ks = 0; ks < 4; ++ks) s = MFMA32(ak[ks], bq[ks], s);
            f32x2 t2[8];
#pragma unroll
            for (int i = 0; i < 4; ++i) {
                const f32x4 bi = *(const f32x4*)(sc + q * SCLD + kt * 32 + 8 * i + 4 * hh);
                t2[2 * i] = (f32x2){s[4 * i], s[4 * i + 1]} * c1 + (f32x2){bi[0], bi[1]};
                t2[2 * i + 1] = (f32x2){s[4 * i + 2], s[4 * i + 3]} * c1 + (f32x2){bi[2], bi[3]};
            }
            float mloc = fmaxf(fmaxf(t2[0].x, t2[0].y), fmaxf(t2[1].x, t2[1].y));
#pragma unroll
            for (int i = 2; i < 8; i += 2) mloc = fmaxf(mloc, fmaxf(fmaxf(t2[i].x, t2[i].y), fmaxf(t2[i + 1].x, t2[i + 1].y)));
            mloc = fmaxf(mloc, __shfl_xor(mloc, 32));
            if (__ballot(mloc > m + 8.f) != 0ull) {
                const float mnew = (mloc > m + 8.f) ? mloc : m;
                const float alpha = fexp2(m - mnew);
                m = mnew;
                lsum *= alpha;
                const f32x2 al2 = (f32x2){alpha, alpha};
#pragma unroll
                for (int e = 0; e < 16; e += 2) {
                    f32x2 a0 = (f32x2){o[0][e], o[0][e + 1]} * al2, a1 = (f32x2){o[1][e], o[1][e + 1]} * al2;
                    o[0][e] = a0.x; o[0][e + 1] = a0.y; o[1][e] = a1.x; o[1][e + 1] = a1.y;
                }
            }
            const f32x2 m2 = (f32x2){m, m};
            f32x2 ps2 = (f32x2){0.f, 0.f};
#pragma unroll
            for (int i = 0; i < 8; ++i) {
                const f32x2 d = t2[i] - m2;
                f32x2 pe; pe.x = fexp2(d.x); pe.y = fexp2(d.y);
                ps2 += pe;
                s[2 * i] = pe.x; s[2 * i + 1] = pe.y;
            }
            lsum += ps2.x + ps2.y;
            bf16x8 pb[2];
#pragma unroll
            for (int s2 = 0; s2 < 2; ++s2) {
                union { uint4 u; bf16x8 v; } cv;
                cv.u = make_uint4(pack2(s[8 * s2], s[8 * s2 + 1]), pack2(s[8 * s2 + 2], s[8 * s2 + 3]),
                                  pack2(s[8 * s2 + 4], s[8 * s2 + 5]), pack2(s[8 * s2 + 6], s[8 * s2 + 7]));
                pb[s2] = cv.v;
            }
#pragma unroll
            for (int dt = 0; dt < 2; ++dt)
#pragma unroll
                for (int s2 = 0; s2 < 2; ++s2) o[dt] = MFMA32(av[dt][s2], pb[s2], o[dt]);
        }
        lsum += __shfl_xor(lsum, 32);
        __syncthreads();
        float* cb = (float*)smem + (wave >> 1) * (64 * 34);
        if (ksp == 1) {
            cb[lane] = m; cb[64 + lane] = lsum;
#pragma unroll
            for (int dt = 0; dt < 2; ++dt)
#pragma unroll
                for (int e = 0; e < 16; ++e) cb[(2 + dt * 16 + e) * 64 + lane] = o[dt][e];
        }
        __syncthreads();
        if (ksp == 0) {
            const float m1 = cb[lane], l1 = cb[64 + lane];
            const float mm = fmaxf(m, m1);
            const float a0 = fexp2(m - mm), a1 = fexp2(m1 - mm);
            const float inv = 1.f / (lsum * a0 + l1 * a1);
            bf16_t* GA = (bf16_t*)(ws + W_GA);
#pragma unroll
            for (int dt = 0; dt < 2; ++dt)
#pragma unroll
                for (int i = 0; i < 4; ++i) {
                    bf16_t* gp = GA + (size_t)(tok0 + q) * 512 + head * 64 + dt * 32 + 8 * i + 4 * hh;
                    const uint2 gv = *(const uint2*)gp;
                    float r[4];
#pragma unroll
                    for (int j = 0; j < 4; ++j) r[j] = (o[dt][4 * i + j] * a0 + cb[(2 + dt * 16 + 4 * i + j) * 64 + lane] * a1) * inv;
                    bf16_t* op = dummy_out ? (bf16_t*)(ws + W_H + (size_t)NTOK * 1024) + (gp - GA) : gp;
                    st_bf4(op, r[0] * bflo(gv.x), r[1] * bfhi(gv.x), r[2] * bflo(gv.y), r[3] * bfhi(gv.y));
                }
        }
        __syncthreads();
    }
}

__device__ __forceinline__ void ssm_task(const Params& P, int task, char* hs  ) {
    const int lane = threadIdx.x & 63, l32 = lane & 31, hh = lane >> 5;
    char* ws = P.ws;
    const bf16_t* U = (const bf16_t*)(ws + W_U);
    const float* E = (const float*)(ws + W_E);
    const float* A1 = (const float*)(ws + W_A1);
    bool smp; int b, g, j64, tb;
    if (task < 16384) { smp = false; g = task & 31; j64 = (task >> 5) & 31; b = task >> 10; tb = b * 2048 + j64 * 64; }
    else { const int s = task - 16384; smp = true; g = s & 31; b = s >> 5; j64 = 0; tb = NP + b * 64; }
    f32x16 bu[2][4];
    {
        bf16x8 au[2], bb[4];
#pragma unroll
        for (int rt = 0; rt < 2; ++rt) {
            const int tau = 32 * ((l32 >> 2) & 1) + 16 * rt + 4 * (l32 >> 3) + (l32 & 3);
            au[rt] = *(const bf16x8*)(U + (size_t)(tb + tau) * 512 + g * 16 + 8 * hh);
        }
        const bf16_t* Bt = (const bf16_t*)(ws + W_BT);
#pragma unroll
        for (int ct = 0; ct < 4; ++ct) bb[ct] = *(const bf16x8*)(Bt + ((size_t)g * 128 + ct * 32 + l32) * 16 + 8 * hh);
        f32x16 z;
#pragma unroll
        for (int e = 0; e < 16; ++e) z[e] = 0.f;
#pragma unroll
        for (int rt = 0; rt < 2; ++rt)
#pragma unroll
            for (int ct = 0; ct < 4; ++ct) bu[rt][ct] = MFMA32(au[rt], bb[ct], z);
    }
    float cr[2], ci[2];
#pragma unroll
    for (int sp = 0; sp < 2; ++sp) {
        const int p = 32 * sp + l32;
        if (!smp) {
            const float* ep = E + (((size_t)b * 64 + 2 * j64 + hh) * 32 + g) * 128 + p;
            cr[sp] = ep[0]; ci[sp] = ep[64];
        } else {
            const float* ep = E + (((size_t)1024 + b) * 32 + g) * 128 + p;
            const float* h0r = P.st_re + (size_t)(b * 32 + g) * 64 + p;
            const float* h0i = P.st_im + (size_t)(b * 32 + g) * 64 + p;
            cr[sp] = hh ? ep[0] : h0r[0];
            ci[sp] = hh ? ep[64] : h0i[0];
        }
    }
#pragma unroll
    for (int sp = 0; sp < 2; ++sp) {
        const int p = 32 * sp + l32, gp = g * 64 + p;
        const float ar = A1[gp * 2], ai = A1[gp * 2 + 1];
        float hr = cr[sp], hi = ci[sp];
#pragma unroll
        for (int rt = 0; rt < 2; ++rt)
#pragma unroll
            for (int e = 0; e < 16; ++e) {
                const float nr = ar * hr - ai * hi + bu[rt][sp][e];
                const float ni = ar * hi + ai * hr + bu[rt][sp + 2][e];
                hr = nr; hi = ni;
                bu[rt][sp][e] = hr; bu[rt][sp + 2][e] = hi;
            }
        if (hh == 1 && (smp || j64 == 31)) {
            float* ore = P.out + (smp ? O_HRS : O_HRP) + (size_t)(b * 32 + g) * 64 + p;
            float* oim = P.out + (smp ? O_HIS : O_HIP) + (size_t)(b * 32 + g) * 64 + p;
            *ore = hr; *oim = hi;
        }
    }
    asm volatile("s_waitcnt lgkmcnt(0)" ::: "memory");
#pragma unroll
    for (int rt = 0; rt < 2; ++rt)
#pragma unroll
        for (int e = 0; e < 16; ++e) {
            const int tau = 32 * hh + 16 * rt + e;
            uint2 v; v.x = pack2(bu[rt][0][e], bu[rt][1][e]); v.y = pack2(bu[rt][2][e], bu[rt][3][e]);
            *(uint2*)(hs + tau * 272 + l32 * 8) = v;
        }
    asm volatile("s_waitcnt lgkmcnt(0)" ::: "memory");
    __builtin_amdgcn_wave_barrier();
    {
        const bf16_t* Cc = (const bf16_t*)(ws + W_CC);
        bf16_t* YG = (bf16_t*)(ws + W_H);
        const int l16 = lane & 15, lq = lane >> 4;
        bf16x8 cc[4];
#pragma unroll
        for (int ks = 0; ks < 4; ++ks) cc[ks] = *(const bf16x8*)(Cc + ((size_t)g * 16 + l16) * 128 + 32 * ks + 8 * lq);
        const int ch = g * 16 + l16;
        const float dsk = P.d_skip[ch];
#pragma unroll
        for (int r16 = 0; r16 < 4; ++r16) {
            f32x4 y = {0.f, 0.f, 0.f, 0.f};
#pragma unroll
            for (int ks = 0; ks < 4; ++ks) {
                const bf16x8 a = *(const bf16x8*)(hs + (16 * r16 + l16) * 272 + (32 * ks + 8 * lq) * 2);
                y = MFMA16(a, cc[ks], y);
            }
#pragma unroll
            for (int j = 0; j < 4; ++j) {
                const size_t idx = (size_t)(tb + 16 * r16 + 4 * lq + j) * 512 + ch;
                const float u = bf2f(U[idx]);
                YG[idx] = f2bf(geluf_(y[j] + dsk * u));
            }
        }
    }
    asm volatile("s_waitcnt lgkmcnt(0)" ::: "memory");
    __builtin_amdgcn_wave_barrier();
}

__device__ __forceinline__ void phase4(const Params& P, char* smem, bool dummy_out = false) {
    const int tid = threadIdx.x, lane = tid & 63, wave = tid >> 6;
    unsigned* cnt = (unsigned*)(P.ws + W_CNT);
    int* slot = (int*)(smem + 16 * SCLD * 4);
    int pend = 0;
    if (tid == 0) pend = (int)atomicAdd(cnt + 0, 1u);
    for (;;) {
        if (tid == 0) *slot = pend;
        __syncthreads();
        const int task = *slot;
        if (task >= 2048 + 128) break;
        if (tid == 0) pend = (int)atomicAdd(cnt + 0, 1u);
        attn_task(P, task, smem, dummy_out);
    }
    __syncthreads();
    char* hs = smem + wave * 17408;
    unsigned* cnt2 = (unsigned*)(P.ws + W_CNT2);
    const int xcs = (int)(__builtin_amdgcn_s_getreg((3 << 11) | 20) & 7u);
    int kqs = 0;
    for (;;) {
        int chunk = -1;
        if (lane == 0) {
            while (kqs < 8) {
                const int x = (xcs + kqs) & 7;
                const int l = (int)atomicAdd(cnt2 + 64 * x, 1u);
                if (l < 544) { chunk = x * 544 + l; break; }
                ++kqs;
            }
        }
        chunk = __shfl(chunk, 0);
        if (chunk < 0) break;
        for (int i = 0; i < 4; ++i) ssm_task(P, chunk * 4 + i, hs);
    }
}

struct EpiGlu {
    Params P;
    __device__ __forceinline__ void operator()(const f32x4 (&acc)[2][2][4][2], const pg8::Unit& u, int wr, int wc, int fr, int fq) const {
        const bf16_t* GS = (const bf16_t*)(P.ws + W_GS);
        bf16_t* T2 = (bf16_t*)(P.ws + W_U);
        uint2 gv[2][4][2];
#pragma unroll
        for (int ai = 0; ai < 2; ++ai)
#pragma unroll
            for (int m = 0; m < 4; ++m)
#pragma unroll
                for (int bj = 0; bj < 2; ++bj) {
                    const int tok = u.pm * 256 + ai * 128 + wr * 64 + m * 16 + fr;
                    gv[ai][m][bj] = *(const uint2*)(GS + (size_t)tok * 512 + u.pn * 128 + bj * 64 + wc * 16 + 4 * fq);
                }
#pragma unroll
        for (int ai = 0; ai < 2; ++ai)
#pragma unroll
            for (int m = 0; m < 4; ++m)
#pragma unroll
                for (int bj = 0; bj < 2; ++bj) {
                    const int tok = u.pm * 256 + ai * 128 + wr * 64 + m * 16 + fr;
                    const size_t idx = (size_t)tok * 512 + u.pn * 128 + bj * 64 + wc * 16 + 4 * fq;
                    const uint2 g = gv[ai][m][bj];
                    const f32x4 va = acc[ai][bj][m][0], ga = act4<2>(acc[ai][bj][m][1]);
                    st_bf4(T2 + idx, va[0] * ga[0] * bflo(g.x), va[1] * ga[1] * bfhi(g.x), va[2] * ga[2] * bflo(g.y), va[3] * ga[3] * bfhi(g.y));
                }
    }
};
__device__ __forceinline__ void phase5(const Params& P, char* smem);
template <int PART>
struct EpiMerge {
    Params P;
    __device__ __forceinline__ void operator()(const f32x4 (&acc)[2][2][4][2], const pg8::Unit& u, int wr, int wc, int fr, int fq) const {
        const bf16_t* MX = (const bf16_t*)(P.ws + (PART == 0 ? W_MA : W_MB));
        bf16_t* MG = (bf16_t*)(P.ws + W_Q);
#pragma unroll
        for (int ai = 0; ai < 2; ++ai) {
            uint4 mv[4][2], pv[4][2];
#pragma unroll
            for (int m = 0; m < 4; ++m)
#pragma unroll
                for (int bj = 0; bj < 2; ++bj) {
                    const int tok = u.pm * 256 + ai * 128 + wr * 64 + m * 16 + fr;
                    const size_t idx = (size_t)tok * 1024 + u.pn * 256 + bj * 128 + wc * 32 + 8 * fq;
                    mv[m][bj] = *(const uint4*)(MX + idx);
                    if (PART == 1) pv[m][bj] = *(const uint4*)(MG + idx);
                }
#pragma unroll
            for (int m = 0; m < 4; ++m)
#pragma unroll
                for (int bj = 0; bj < 2; ++bj) {
                    const int tok = u.pm * 256 + ai * 128 + wr * 64 + m * 16 + fr;
                    const size_t idx = (size_t)tok * 1024 + u.pn * 256 + bj * 128 + wc * 32 + 8 * fq;
                    const uint4 a = mv[m][bj];
                    f32x4 r0 = acc[ai][bj][m][0], r1 = acc[ai][bj][m][1];
                    r0[0] *= bflo(a.x); r0[1] *= bfhi(a.x); r0[2] *= bflo(a.y); r0[3] *= bfhi(a.y);
                    r1[0] *= bflo(a.z); r1[1] *= bfhi(a.z); r1[2] *= bflo(a.w); r1[3] *= bfhi(a.w);
                    if (PART == 1) {
                        const uint4 b = pv[m][bj];
                        r0[0] += bflo(b.x); r0[1] += bfhi(b.x); r0[2] += bflo(b.y); r0[3] += bfhi(b.y);
                        r1[0] += bflo(b.z); r1[1] += bfhi(b.z); r1[2] += bflo(b.w); r1[3] += bfhi(b.w);
                    }
                    st_bf8(MG + idx, r0, r1);
                }
        }
    }
};
__device__ __forceinline__ void phase5(const Params& P, char* smem) {
    {
        pg8::StaticOrder S; S.init(NTOK, 1024, (int)gridDim.x, (int)blockIdx.x);
        pg8::Gemm g{(const bf16_t*)(P.ws + W_H), (const bf16_t*)(P.ws + W_WTGLU), NTOK, 1024, 512};
        EpiGlu E{P};
        pg8::gemm_phase((PG8_LAS unsigned char*)smem, g, S, E);
    }
    {
        pg8::StaticOrder S; S.init(NTOK, 1024, (int)gridDim.x, (int)(gridDim.x - 1 - blockIdx.x));
        pg8::Gemm g{(const bf16_t*)(P.ws + W_GA), (const bf16_t*)(P.ws + W_WTAP), NTOK, 1024, 512};
        EpiMerge<0> E{P};
        pg8::gemm_phase((PG8_LAS unsigned char*)smem, g, S, E);
    }
}
__device__ __forceinline__ void phase6(const Params& P, char* smem) {
    pg8::StaticOrder S; S.init(NTOK, 1024, (int)gridDim.x, (int)blockIdx.x);
    pg8::Gemm g{(const bf16_t*)(P.ws + W_U), (const bf16_t*)(P.ws + W_WTSP), NTOK, 1024, 512};
    EpiMerge<1> E{P};
    pg8::gemm_phase((PG8_LAS unsigned char*)smem, g, S, E);
}

struct EpiOut {
    Params P;
    __device__ __forceinline__ void operator()(const f32x4 (&acc)[2][2][4][2], const pg8::Unit& u, int wr, int wc, int fr, int fq) const {
        const float* modf = (const float*)(P.ws + W_MODF);
#pragma unroll
        for (int ai = 0; ai < 2; ++ai) {
            f32x4 xv[4][2][2];
#pragma unroll
            for (int m = 0; m < 4; ++m) {
                const float* xr = xrow(P, u.pm * 256 + ai * 128 + wr * 64 + m * 16 + fr);
#pragma unroll
                for (int bj = 0; bj < 2; ++bj) {
                    const int n = u.pn * 256 + bj * 128 + wc * 32 + 8 * fq;
                    xv[m][bj][0] = *(const f32x4*)(xr + n); xv[m][bj][1] = *(const f32x4*)(xr + n + 4);
                }
            }
#pragma unroll
            for (int m = 0; m < 4; ++m) {
                const int tok = u.pm * 256 + ai * 128 + wr * 64 + m * 16 + fr;
                const float* gate = modf + (size_t)modrow(tok) * 3072 + 2048;
#pragma unroll
                for (int bj = 0; bj < 2; ++bj) {
                    const int n = u.pn * 256 + bj * 128 + wc * 32 + 8 * fq;
                    const f32x4 g0 = *(const f32x4*)(gate + n), g1 = *(const f32x4*)(gate + n + 4);
                    float* o = P.out + O_Y + (size_t)tok * 1024 + n;
                    *(f32x4*)o = xv[m][bj][0] + g0 * acc[ai][bj][m][0];
                    *(f32x4*)(o + 4) = xv[m][bj][1] + g1 * acc[ai][bj][m][1];
                }
            }
        }
    }
};
__device__ __forceinline__ void phase7(const Params& P, char* smem) {
    pg8::StaticOrder S; S.init(NTOK, 1024, (int)gridDim.x, (int)blockIdx.x);
    pg8::Gemm g{(const bf16_t*)(P.ws + W_Q), (const bf16_t*)(P.ws + W_WTOUT), NTOK, 1024, 1024};
    EpiOut E{P};
    pg8::gemm_phase((PG8_LAS unsigned char*)smem, g, S, E);
}

__device__ __forceinline__ void phase8(const Params& P, char* smem) {
    const int lane = threadIdx.x & 63, wave = threadIdx.x >> 6;
    for (int tok0 = (blockIdx.x * 8 + wave) * 2; tok0 < NTOK; tok0 += gridDim.x * 16) {
        float4 v[2][4];
#pragma unroll
        for (int r = 0; r < 2; ++r)
#pragma unroll
            for (int i = 0; i < 4; ++i) v[r][i] = *(const float4*)(P.out + O_Y + (size_t)(tok0 + r) * 1024 + 4 * lane + 256 * i);
        float4 g4[4];
#pragma unroll
        for (int i = 0; i < 4; ++i) g4[i] = *(const float4*)(P.g_final + 4 * lane + 256 * i);
#pragma unroll
        for (int r = 0; r < 2; ++r) {
            float* y = P.out + O_Y + (size_t)(tok0 + r) * 1024;
            float ss = 0.f;
#pragma unroll
            for (int i = 0; i < 4; ++i) ss += v[r][i].x * v[r][i].x + v[r][i].y * v[r][i].y + v[r][i].z * v[r][i].z + v[r][i].w * v[r][i].w;
#pragma unroll
            for (int o = 32; o >= 1; o >>= 1) ss += __shfl_xor(ss, o);
            const float rinv = rsqrtf(ss * (1.f / 1024.f) + 1e-6f);
#pragma unroll
            for (int i = 0; i < 4; ++i)
                *(float4*)(y + 4 * lane + 256 * i) = make_float4(v[r][i].x * rinv * g4[i].x, v[r][i].y * rinv * g4[i].y, v[r][i].z * rinv * g4[i].z, v[r][i].w * rinv * g4[i].w);
        }
    }
}

#define XB_TMO      128
#define XB_XCNT(j)  (256  + 64 * (j))
#define XB_XSUB(j)  (1280 + 64 * (j))
#define XB_XGEN(j)  (2304 + 64 * (j))
#define XB_TOP      3328
#define XB_TOPGEN   3392
#define XCD_BAR_WORDS 3456
#define XB_SPIN_CAP (1u << 18)
#define LAS __attribute__((address_space(3)))
__device__ __forceinline__ unsigned xb_ld(unsigned* p)              { return __hip_atomic_load(p, __ATOMIC_RELAXED, __HIP_MEMORY_SCOPE_AGENT); }
__device__ __forceinline__ unsigned xb_add(unsigned* p, unsigned v) { return __hip_atomic_fetch_add(p, v, __ATOMIC_RELAXED, __HIP_MEMORY_SCOPE_AGENT); }
__device__ __forceinline__ unsigned xb_xcc_id() { return (unsigned)__builtin_amdgcn_s_getreg((3 << 11) | 20) & 0xFu; }
#define XB_SPIN(cond, bar) do { unsigned _sp = 0; while (cond) { __builtin_amdgcn_s_sleep(1); \
    if ((++_sp & 255u) == 0u) { if (xb_ld(&(bar)[XB_TMO])) break; if (_sp > XB_SPIN_CAP) { atomicAdd(&(bar)[XB_TMO], 1u); break; } } } } while (0)
struct XcdBarrier { unsigned* bar; unsigned x; volatile LAS unsigned* st; };
__device__ __forceinline__ XcdBarrier xcd_barrier_post(unsigned* bar, volatile LAS unsigned* st) {
    XcdBarrier b; b.bar = bar; b.x = xb_xcc_id(); b.st = st;
    if (threadIdx.x == 0) (void)xb_add(&bar[XB_XCNT(b.x)], 1u);
    return b;
}
__device__ __forceinline__ void xcd_barrier_complete(unsigned* bar, unsigned x, unsigned& nloc, unsigned& nx) {
    const unsigned G = gridDim.x * gridDim.y * gridDim.z;
    unsigned sum, cnt, mine, sp = 0u;
    for (;;) {
        sum = 0u; cnt = 0u; mine = 0u;
#pragma unroll
        for (unsigned j = 0; j < 16; ++j) { const unsigned c = xb_ld(&bar[XB_XCNT(j)]); sum += c; cnt += (c > 0u) ? 1u : 0u; mine = (j == x) ? c : mine; }
        if (sum == G) break;
        __builtin_amdgcn_s_sleep(1);
        if ((++sp & 255u) == 0u) { if (xb_ld(&bar[XB_TMO])) break; if (sp > XB_SPIN_CAP) { atomicAdd(&bar[XB_TMO], 1u); break; } }
    }
    nloc = mine > 0u ? mine : 1u; nx = cnt > 0u ? cnt : 1u;
}
__device__ __forceinline__ void xcd_barrier(const XcdBarrier& b) {
    asm volatile("s_waitcnt vmcnt(0)" ::: "memory");
    __syncthreads();
    if (threadIdx.x == 0) {
        unsigned* bar = b.bar;
        __builtin_amdgcn_s_waitcnt(0);
        unsigned nloc = b.st[0], nx = b.st[1];
        if (nloc == 0u) { xcd_barrier_complete(bar, b.x, nloc, nx); b.st[0] = nloc; b.st[1] = nx; }
        const unsigned old = xb_add(&bar[XB_XSUB(b.x)], 1u);
        const unsigned gen = old / nloc;
        if (old + 1u == (gen + 1u) * nloc) {
            __builtin_amdgcn_fence(__ATOMIC_RELEASE, "agent");
            asm volatile("s_waitcnt vmcnt(0)" ::: "memory");
            const unsigned og = xb_add(&bar[XB_TOP], 1u);
            const unsigned tg = og / nx;
            if (og + 1u == (tg + 1u) * nx) xb_add(&bar[XB_TOPGEN], 1u);
            else XB_SPIN(xb_ld(&bar[XB_TOPGEN]) == tg, bar);
            __builtin_amdgcn_fence(__ATOMIC_ACQUIRE, "agent");
            xb_add(&bar[XB_XGEN(b.x)], 1u);
            asm volatile("s_waitcnt vmcnt(0)" ::: "memory");
        } else {
            XB_SPIN(xb_ld(&bar[XB_XGEN(b.x)]) == gen, bar);
            __builtin_amdgcn_fence(__ATOMIC_ACQUIRE, "agent");
            asm volatile("s_waitcnt vmcnt(0)" ::: "memory");
        }
    }
    __syncthreads();
}

extern __shared__ __attribute__((aligned(16))) char dyn_smem[];

#ifndef REP2
#define REP2 0
#endif
#ifndef REP4
#define REP4 0
#endif
#ifndef REPSYNC
#define REPSYNC 1
#endif
#define GSYNC() xcd_barrier(xb)
__global__ void __launch_bounds__(NTHREADS) mega_kernel(Params P) {
    cg::grid_group grid = cg::this_grid();
    volatile LAS unsigned* xst = (volatile LAS unsigned*)(dyn_smem + SMEM_BYTES - 16);
    if (threadIdx.x == 0) { xst[0] = 0u; xst[1] = 0u; }
    __syncthreads();
    XcdBarrier xb = xcd_barrier_post((unsigned*)(P.ws + W_BAR), xst);
    if (P.out == nullptr) grid.sync();
    phase0(P, dyn_smem); GSYNC();
    phase1(P, dyn_smem); GSYNC();
    phase2(P, dyn_smem); GSYNC();
#if REP2
    phase2(P, dyn_smem); GSYNC();
#endif
    phase3(P, dyn_smem); GSYNC();
#if REP4
    phase4(P, dyn_smem, true); GSYNC();
    if (blockIdx.x == 0 && threadIdx.x < 64) ((unsigned*)(P.ws + W_CNT))[threadIdx.x] = 0u;
    GSYNC();
#endif
    phase4(P, dyn_smem); GSYNC();
    phase5(P, dyn_smem); GSYNC();
    phase6(P, dyn_smem); GSYNC();
    phase7(P, dyn_smem); GSYNC();
    phase8(P, dyn_smem);
}

template <int PH>
__global__ void __launch_bounds__(NTHREADS) phase_kernel(Params P) {
    if (PH == 0) phase0(P, dyn_smem);
    if (PH == 1) phase1(P, dyn_smem);
    if (PH == 2) phase2(P, dyn_smem);
    if (PH == 3) phase3(P, dyn_smem);
    if (PH == 4) phase4(P, dyn_smem);
    if (PH == 5) phase5(P, dyn_smem);
    if (PH == 6) phase6(P, dyn_smem);
    if (PH == 7) phase7(P, dyn_smem);
    if (PH == 8) phase8(P, dyn_smem);
}

template <int PH>
static void launch_phase(const Params& p, hipStream_t stream) {
    static bool attr = false;
    if (!attr) { (void)hipFuncSetAttribute((const void*)phase_kernel<PH>, hipFuncAttributeMaxDynamicSharedMemorySize, SMEM_BYTES); attr = true; }
    phase_kernel<PH><<<256, NTHREADS, SMEM_BYTES, stream>>>(p);
}

extern "C" void kernel_launch(void* const* d_in, const int* in_sizes, int n_in, void* d_out, int out_size, void* d_ws, size_t ws_size,
                              hipStream_t stream) {
    Params p{};
    const float* const* in = (const float* const*)d_in;
    p.x_prompt = in[0]; p.x_sample = in[1]; p.cache_k = in[2]; p.cache_v = in[3]; p.cache_idx_k = in[4];
    p.st_re = in[5]; p.st_im = in[6]; p.c_prompt = in[7]; p.c_sample = in[8];
    p.w_mod = in[9]; p.b_mod = in[10]; p.g_norm = in[11]; p.w_in = in[12];
    p.lam_re = in[13]; p.lam_im = in[14]; p.log_dt = in[15]; p.b_re = in[16]; p.b_im = in[17];
    p.c_re = in[18]; p.c_im = in[19]; p.d_skip = in[20]; p.w_glu = in[21]; p.w_ap = in[22]; p.w_sp = in[23];
    p.w_out = in[24]; p.g_final = in[25];
    p.out = (float*)d_out;
    p.ws = (char*)d_ws;
    if (ws_size < W_END) { fprintf(stderr, "workspace too small: %zu < %zu\n", ws_size, (size_t)W_END); return; }
#if MEGA
    static int grid_blocks = 0;
    if (!grid_blocks) {
        (void)hipFuncSetAttribute((const void*)mega_kernel, hipFuncAttributeMaxDynamicSharedMemorySize, SMEM_BYTES);
        int dev = 0, cus = 0, per_cu = 0;
        (void)hipGetDevice(&dev);
        (void)hipDeviceGetAttribute(&cus, hipDeviceAttributeMultiprocessorCount, dev);
        (void)hipOccupancyMaxActiveBlocksPerMultiprocessor(&per_cu, mega_kernel, NTHREADS, SMEM_BYTES);
        if (per_cu > 1) per_cu = 1;
        grid_blocks = cus * per_cu;
    }
    (void)hipMemsetAsync(p.ws + W_CNT, 0, W_WTIN - W_CNT, stream);
    void* args[] = {&p};
    hipError_t e = hipLaunchCooperativeKernel((void*)mega_kernel, dim3(grid_blocks), dim3(NTHREADS), args, SMEM_BYTES, stream);
    if (e != hipSuccess) fprintf(stderr, "cooperative launch failed: %s (grid %d)\n", hipGetErrorString(e), grid_blocks);
#else
    (void)hipMemsetAsync(p.ws + W_CNT, 0, W_WTIN - W_CNT, stream);
#ifndef PROBE_SET
#define PROBE_SET 0
#endif
    launch_phase<0>(p, stream); if (PROBE_SET & 1) launch_phase<0>(p, stream);
    launch_phase<1>(p, stream); if (PROBE_SET & 2) launch_phase<1>(p, stream);
    launch_phase<2>(p, stream); if (PROBE_SET & 4) launch_phase<2>(p, stream);
    launch_phase<3>(p, stream); if (PROBE_SET & 8) launch_phase<3>(p, stream);
    launch_phase<4>(p, stream);
    launch_phase<5>(p, stream); if (PROBE_SET & 32) launch_phase<5>(p, stream);
    launch_phase<6>(p, stream); if (PROBE_SET & 64) launch_phase<6>(p, stream);
    launch_phase<7>(p, stream); if (PROBE_SET & 128) launch_phase<7>(p, stream);
    launch_phase<8>(p, stream);
#endif
}
```
